# Optimizing an MI355X kernel written in HIP

```python
import math
import jax, jax.numpy as jnp
from jax import lax
import numpy as np

D_MODEL = 2048
BATCH = 4
SEQ = 2048
DEPTH = 1

MLA_HEADS = 8
QK_NOPE_DIM = 128
QK_ROPE_DIM = 64
V_HEAD_DIM = 128
Q_LORA_RANK = 768
KV_LORA_RANK = 512
ROPE_THETA = 10000.0
ATTN_BLOCK = 128
MLA_WIDTH = MLA_HEADS * V_HEAD_DIM

SGU_GROUPS = 8
SGU_GROUP_DIM = 128
SGU_CHUNK = 128
SGU_WIDTH = SGU_GROUPS * SGU_GROUP_DIM

MIX_WIDTH = MLA_WIDTH + SGU_WIDTH
IN_PROJ_DIM = Q_LORA_RANK + KV_LORA_RANK + QK_ROPE_DIM + 2 * SGU_WIDTH

N_GROUPS = 4
EXPERTS_PER_GROUP = 8
N_EXPERTS = N_GROUPS * EXPERTS_PER_GROUP
TOP_K_EXPERTS = 2
EXPERT_FF = 512

DEEPNORM_ALPHA = (2 * DEPTH) ** 0.25
DEEPNORM_BETA = (8 * DEPTH) ** -0.25
EPS = 1e-6
N_MOD = 6

kernel_name = "hymba_mla_sgu_hiermoe_deepnorm_adaln"


def _layernorm(x, g=None, b=None):
    xf = x.astype(jnp.float32)
    mu = jnp.mean(xf, axis=-1, keepdims=True)
    var = jnp.mean(jnp.square(xf - mu), axis=-1, keepdims=True)
    y = (xf - mu) * lax.rsqrt(var + EPS)
    if g is not None:
        y = y * g.astype(jnp.float32) + b.astype(jnp.float32)
    return y.astype(x.dtype)


def _rmsnorm(x, g):
    xf = x.astype(jnp.float32)
    y = xf * lax.rsqrt(jnp.mean(jnp.square(xf), axis=-1, keepdims=True) + EPS)
    return (y * g.astype(jnp.float32)).astype(x.dtype)


def _rope(x, cos, sin):
    x1, x2 = jnp.split(x, 2, axis=-1)
    return jnp.concatenate([x1 * cos - x2 * sin, x2 * cos + x1 * sin], axis=-1)


def _causal_block_attention(q, k, v):
    B, S, H, Dk = q.shape
    nb = S // ATTN_BLOCK
    scale = Dk ** -0.5
    q_blocks = q.reshape(B, nb, ATTN_BLOCK, H, Dk).transpose(1, 0, 2, 3, 4)
    key_pos = jnp.arange(S)

    def one_block(args):
        qb, bi = args
        s = jnp.einsum('bqhd,bkhd->bhqk', qb, k).astype(jnp.float32) * scale
        q_pos = bi * ATTN_BLOCK + jnp.arange(ATTN_BLOCK)
        mask = key_pos[None, :] <= q_pos[:, None]
        s = jnp.where(mask, s, -1e30)
        p = jax.nn.softmax(s, axis=-1).astype(v.dtype)
        return jnp.einsum('bhqk,bkhd->bqhd', p, v)

    out = lax.map(one_block, (q_blocks, jnp.arange(nb)))
    return out.transpose(1, 0, 2, 3, 4).reshape(B, S, H, v.shape[-1])


def _mixer(h, positions, w_in, q_norm_g, w_uq, kv_norm_g, w_ukv,
           sgu_norm_g, sgu_norm_b, w_spatial, b_spatial, w_o):
    B, S, _ = h.shape
    proj = h @ w_in
    c_q, c_kv, k_pe, z = jnp.split(
        proj, [Q_LORA_RANK, Q_LORA_RANK + KV_LORA_RANK, Q_LORA_RANK + KV_LORA_RANK + QK_ROPE_DIM], axis=-1)

    q = (_rmsnorm(c_q, q_norm_g) @ w_uq).reshape(B, S, MLA_HEADS, QK_NOPE_DIM + QK_ROPE_DIM)
    q_nope, q_pe = jnp.split(q, [QK_NOPE_DIM], axis=-1)
    kv = (_rmsnorm(c_kv, kv_norm_g) @ w_ukv).reshape(B, S, MLA_HEADS, QK_NOPE_DIM + V_HEAD_DIM)
    k_nope, v = jnp.split(kv, [QK_NOPE_DIM], axis=-1)
    inv_freq = 1.0 / (ROPE_THETA ** (jnp.arange(0, QK_ROPE_DIM, 2, dtype=jnp.float32) / QK_ROPE_DIM))
    ang = positions.astype(jnp.float32)[..., None] * inv_freq
    cos = jnp.cos(ang).astype(h.dtype)
    sin = jnp.sin(ang).astype(h.dtype)
    q_pe = _rope(q_pe, cos[:, :, None, :], sin[:, :, None, :])
    k_pe = _rope(k_pe, cos, sin)
    q_full = jnp.concatenate([q_nope, q_pe], axis=-1)
    k_full = jnp.concatenate(
        [k_nope, jnp.broadcast_to(k_pe[:, :, None, :], (B, S, MLA_HEADS, QK_ROPE_DIM))], axis=-1)
    attn = _causal_block_attention(q_full, k_full, v).reshape(B, S, MLA_WIDTH)

    u, vs = jnp.split(jax.nn.gelu(z), 2, axis=-1)
    vs = _layernorm(vs, sgu_norm_g, sgu_norm_b)
    nc = S // SGU_CHUNK
    vs = vs.reshape(B, nc, SGU_CHUNK, SGU_GROUPS, SGU_GROUP_DIM)
    causal = jnp.tril(jnp.ones((SGU_CHUNK, SGU_CHUNK), dtype=bool))
    ws = jnp.where(causal[None], w_spatial, jnp.zeros_like(w_spatial))
    mixed = jnp.einsum('gts,bcsgd->bctgd', ws, vs) + b_spatial.T[None, None, :, :, None]
    sgu = u * mixed.reshape(B, S, SGU_WIDTH)

    return jnp.concatenate([attn, sgu], axis=-1) @ w_o


def _hier_moe(h, w_router_group, b_router_group, w_router_expert, b_router_expert,
              w_gate, w_up, w_down):
    B, S, D = h.shape
    xt = h.reshape(B * S, D)
    lg = (xt @ w_router_group + b_router_group).astype(jnp.float32)
    pg = jax.nn.softmax(lg, axis=-1)
    pg_top, g_idx = lax.top_k(pg, 1)
    le = (xt @ w_router_expert + b_router_expert).astype(jnp.float32).reshape(-1, N_GROUPS, EXPERTS_PER_GROUP)
    le_sel = jnp.take_along_axis(le, g_idx[:, :, None], axis=1)[:, 0]
    pe = jax.nn.softmax(le_sel, axis=-1)
    pe_top, e_idx = lax.top_k(pe, TOP_K_EXPERTS)
    pe_top = pe_top / jnp.sum(pe_top, axis=-1, keepdims=True)
    weights = pg_top * pe_top
    expert_ids = g_idx * EXPERTS_PER_GROUP + e_idx
    combine = jnp.sum(jax.nn.one_hot(expert_ids, N_EXPERTS, dtype=jnp.float32) * weights[..., None], axis=1)
    combine = combine.astype(h.dtype)
    out = jnp.zeros_like(xt)
    for e in range(N_EXPERTS):
        hid = jax.nn.silu(xt @ w_gate[e]) * (xt @ w_up[e])
        out = out + combine[:, e:e + 1] * (hid @ w_down[e])
    return out.reshape(B, S, D)


def setup_inputs(seed: int = 0) -> dict:
    key = jax.random.key(seed)
    ks = jax.random.split(key, 26)
    L, D = DEPTH, D_MODEL
    f32 = jnp.float32

    def nrm(k, shape, scale):
        return jax.random.normal(k, shape, f32) * scale

    x = jax.random.normal(ks[0], (BATCH, SEQ, D), f32)
    c = jax.random.normal(ks[1], (BATCH, D), f32)
    offsets = jax.random.randint(ks[2], (BATCH,), 0, 4096, dtype=jnp.int32)
    positions = (offsets[:, None] + jnp.arange(SEQ, dtype=jnp.int32)[None, :]).astype(jnp.int32)
    return {
        "x": x,
        "c": c,
        "positions": positions,
        "w_ada": nrm(ks[3], (L, D, N_MOD * D), 0.5 * D ** -0.5),
        "b_ada": nrm(ks[4], (L, N_MOD * D), 0.01),
        "w_in": nrm(ks[5], (L, D, IN_PROJ_DIM), D ** -0.5),
        "q_norm_g": 1.0 + nrm(ks[6], (L, Q_LORA_RANK), 0.02),
        "w_uq": nrm(ks[7], (L, Q_LORA_RANK, MLA_HEADS * (QK_NOPE_DIM + QK_ROPE_DIM)), Q_LORA_RANK ** -0.5),
        "kv_norm_g": 1.0 + nrm(ks[8], (L, KV_LORA_RANK), 0.02),
        "w_ukv": nrm(ks[9], (L, KV_LORA_RANK, MLA_HEADS * (QK_NOPE_DIM + V_HEAD_DIM)), KV_LORA_RANK ** -0.5),
        "sgu_norm_g": 1.0 + nrm(ks[10], (L, SGU_WIDTH), 0.02),
        "sgu_norm_b": nrm(ks[11], (L, SGU_WIDTH), 0.01),
        "w_spatial": nrm(ks[12], (L, SGU_GROUPS, SGU_CHUNK, SGU_CHUNK), SGU_CHUNK ** -0.5),
        "b_spatial": 1.0 + nrm(ks[13], (L, SGU_GROUPS, SGU_CHUNK), 0.02),
        "w_o": nrm(ks[14], (L, MIX_WIDTH, D), DEEPNORM_BETA * MIX_WIDTH ** -0.5),
        "ln1_g": 1.0 + nrm(ks[15], (L, D), 0.02),
        "ln1_b": nrm(ks[16], (L, D), 0.01),
        "w_router_group": nrm(ks[17], (L, D, N_GROUPS), D ** -0.5),
        "b_router_group": nrm(ks[18], (L, N_GROUPS), 0.01),
        "w_router_expert": nrm(ks[19], (L, D, N_EXPERTS), D ** -0.5),
        "b_router_expert": nrm(ks[20], (L, N_EXPERTS), 0.01),
        "w_gate": nrm(ks[21], (L, N_EXPERTS, D, EXPERT_FF), D ** -0.5),
        "w_up": nrm(ks[22], (L, N_EXPERTS, D, EXPERT_FF), D ** -0.5),
        "w_down": nrm(ks[23], (L, N_EXPERTS, EXPERT_FF, D), DEEPNORM_BETA * EXPERT_FF ** -0.5),
        "ln2_g": 1.0 + nrm(ks[24], (L, D), 0.02),
        "ln2_b": nrm(ks[25], (L, D), 0.01),
    }


def reference(x, c, positions, w_ada, b_ada, w_in, q_norm_g, w_uq, kv_norm_g, w_ukv,
              sgu_norm_g, sgu_norm_b, w_spatial, b_spatial, w_o, ln1_g, ln1_b,
              w_router_group, b_router_group, w_router_expert, b_router_expert,
              w_gate, w_up, w_down, ln2_g, ln2_b):
    for l in range(DEPTH):
        mod = (c @ w_ada[l] + b_ada[l])[:, None, :]
        sh1, sc1, g1, sh2, sc2, g2 = jnp.split(mod, N_MOD, axis=-1)
        h = _layernorm(x) * (1.0 + sc1) + sh1
        y = _mixer(h, positions, w_in[l], q_norm_g[l], w_uq[l], kv_norm_g[l], w_ukv[l],
                   sgu_norm_g[l], sgu_norm_b[l], w_spatial[l], b_spatial[l], w_o[l])
        x = _layernorm(DEEPNORM_ALPHA * x + g1 * y, ln1_g[l], ln1_b[l])
        h = _layernorm(x) * (1.0 + sc2) + sh2
        y = _hier_moe(h, w_router_group[l], b_router_group[l], w_router_expert[l], b_router_expert[l],
                      w_gate[l], w_up[l], w_down[l])
        x = _layernorm(DEEPNORM_ALPHA * x + g2 * y, ln2_g[l], ln2_b[l])
    return x
```

```cpp
#include <hip/hip_runtime.h>
#include <cstdio>
#include <cstdint>

constexpr int NB = 4, SEQ = 2048, NT = NB * SEQ, D = 2048;
constexpr int QL = 768, KVL = 512, ROPE = 64, NOPE = 128, VD = 128, NH = 8, QKD = NOPE + ROPE;
constexpr int SGW = 1024, NG = 8, GD = 128, CH = 128;
constexpr int INP = QL + KVL + ROPE + 2 * SGW;
constexpr int NE = 32, EPG = 8, NGRP = 4, FF = 512;
constexpr int NMOD = 6 * D;
constexpr float EPS = 1e-6f;
constexpr float ALPHA = 1.189207115002721f;
constexpr float QSCALE = 0.07216878364870323f * 1.4426950408889634f;
constexpr int NPQ = 12, NPKV = 8, NPVS = 16;
constexpr int HIDROWS = 24576;

constexpr size_t MiB = 1u << 20;
constexpr size_t WS_CTL = 0, CTL_BYTES = 1 * MiB;
constexpr size_t WS_MOD = 1 * MiB, WS_ROPE = 2 * MiB, WS_SSQQ = 4 * MiB, WS_SSQKV = 5 * MiB, WS_VSST = 6 * MiB, WS_TOKE = 7 * MiB, WS_TOKW = 7 * MiB + 512 * 1024, WS_LIST = 8 * MiB;
constexpr size_t WS_WIN = 10 * MiB, WS_WUQ = 24 * MiB, WS_WUKV = 27 * MiB, WS_WO = 29 * MiB, WS_WGU = 37 * MiB, WS_WDN = 165 * MiB, WS_WSP = 229 * MiB, WS_WR = 230 * MiB;
constexpr size_t WS_H = 231 * MiB, WS_CQ = 263 * MiB, WS_CKV = 275 * MiB, WS_U = 283 * MiB, WS_VS = 299 * MiB, WS_Q = 315 * MiB, WS_K = 339 * MiB, WS_V = 363 * MiB;
constexpr size_t WS_A2 = 379 * MiB, WS_HID = 411 * MiB, WS_Y2 = 435 * MiB, WS_END = 499 * MiB;
constexpr size_t WS_KPERAW = WS_Y2, WS_QPERAW = WS_Y2 + 2 * MiB, WS_G = WS_Q;
constexpr int CW_CNT = 1024;

typedef unsigned short bf16;
__device__ __forceinline__ bf16 f2bf(float f) { unsigned u = __float_as_uint(f); u += 0x7fffu + ((u >> 16) & 1u); return (bf16)(u >> 16); }
__device__ __forceinline__ float bf2f(bf16 b) { return __uint_as_float(((unsigned)b) << 16); }
__device__ __forceinline__ float wave_sum(float v) {
#pragma unroll
    for (int o = 1; o < 64; o <<= 1) v += __shfl_xor(v, o);
    return v;
}
__device__ __forceinline__ float wave_max(float v) {
#pragma unroll
    for (int o = 1; o < 64; o <<= 1) v = fmaxf(v, __shfl_xor(v, o));
    return v;
}
__device__ __forceinline__ float gelu_tanh(float x) { const float u = 0.7978845608028654f * (x + 0.044715f * x * x * x); return 0.5f * x * (1.0f + tanhf(u)); }

__global__ void n_mod(const float* c, const float* w_ada, const float* b_ada, float* mod) {
    const int j = blockIdx.x * 256 + threadIdx.x;
    float a0 = 0, a1 = 0, a2 = 0, a3 = 0;
    for (int k = 0; k < D; ++k) { const float w = w_ada[(size_t)k * NMOD + j]; a0 += c[k] * w; a1 += c[D + k] * w; a2 += c[2 * D + k] * w; a3 += c[3 * D + k] * w; }
    const float bb = b_ada[j];
    mod[j] = a0 + bb; mod[NMOD + j] = a1 + bb; mod[2 * NMOD + j] = a2 + bb; mod[3 * NMOD + j] = a3 + bb;
}
__global__ void n_rope_table(const int* positions, float2* cs) {
    const int idx = blockIdx.x * 256 + threadIdx.x; if (idx >= NT * 32) return;
    const int tok = idx >> 5, i = idx & 31;
    const float inv = 1.0f / powf(10000.0f, (float)(2 * i) / 64.0f);
    const float ang = (float)positions[tok] * inv;
    cs[idx] = make_float2((float)cos((double)ang), (float)sin((double)ang));
}
__global__ void n_ln_mod(const float* x, const float* mod, int sh_off, int sc_off, bf16* out) {
    const int row = blockIdx.x * 4 + (threadIdx.x >> 6), lane = threadIdx.x & 63, b = row / SEQ;
    const float4* xr = (const float4*)(x + (size_t)row * D);
    float4 v[8]; float s = 0;
#pragma unroll
    for (int j = 0; j < 8; ++j) { v[j] = xr[j * 64 + lane]; s += v[j].x + v[j].y + v[j].z + v[j].w; }
    const float mean = wave_sum(s) * (1.0f / D); float q = 0;
#pragma unroll
    for (int j = 0; j < 8; ++j) { v[j].x -= mean; v[j].y -= mean; v[j].z -= mean; v[j].w -= mean; q += v[j].x * v[j].x + v[j].y * v[j].y + v[j].z * v[j].z + v[j].w * v[j].w; }
    const float rstd = rsqrtf(wave_sum(q) * (1.0f / D) + EPS);
    const float4* sh = (const float4*)(mod + (size_t)b * NMOD + sh_off); const float4* sc = (const float4*)(mod + (size_t)b * NMOD + sc_off);
#pragma unroll
    for (int j = 0; j < 8; ++j) { const float4 a = sh[j * 64 + lane], m = sc[j * 64 + lane];
        ushort4 o; o.x = f2bf(v[j].x * rstd * (1.f + m.x) + a.x); o.y = f2bf(v[j].y * rstd * (1.f + m.y) + a.y); o.z = f2bf(v[j].z * rstd * (1.f + m.z) + a.z); o.w = f2bf(v[j].w * rstd * (1.f + m.w) + a.w);
        *(ushort4*)(out + (size_t)row * D + (j * 64 + lane) * 4) = o; }
}

template <class AL, class BL, class EP>
__device__ __forceinline__ void ngemm_tile(int m0, int n0, int M, int K, const AL& al, const BL& bl, const EP& ep) {
    __shared__ float As[16][65]; __shared__ float Bs[16][64];
    const int t = threadIdx.x, tx = t & 15, ty = t >> 4;
    float acc[4][4];
#pragma unroll
    for (int i = 0; i < 4; ++i)
#pragma unroll
        for (int j = 0; j < 4; ++j) acc[i][j] = 0.f;
    for (int k0 = 0; k0 < K; k0 += 16) {
        { const int r = t >> 2, kq = (t & 3) * 4; float v[4] = {0.f, 0.f, 0.f, 0.f}; if (m0 + r < M) al.load4(m0 + r, k0 + kq, v);
          As[kq + 0][r] = v[0]; As[kq + 1][r] = v[1]; As[kq + 2][r] = v[2]; As[kq + 3][r] = v[3]; }
        { const int kk = t >> 4, nq = (t & 15) * 4; const float4 v = bl.load4(k0 + kk, n0 + nq); *(float4*)&Bs[kk][nq] = v; }
        __syncthreads();
#pragma unroll
        for (int kk = 0; kk < 16; ++kk) { float a[4], b[4];
#pragma unroll
            for (int i = 0; i < 4; ++i) a[i] = As[kk][ty * 4 + i];
            const float4 bv = *(const float4*)&Bs[kk][tx * 4]; b[0] = bv.x; b[1] = bv.y; b[2] = bv.z; b[3] = bv.w;
#pragma unroll
            for (int i = 0; i < 4; ++i)
#pragma unroll
                for (int j = 0; j < 4; ++j) acc[i][j] += a[i] * b[j]; }
        __syncthreads();
    }
#pragma unroll
    for (int i = 0; i < 4; ++i)
#pragma unroll
        for (int j = 0; j < 4; ++j) if (m0 + ty * 4 + i < M) ep(m0 + ty * 4 + i, n0 + tx * 4 + j, acc[i][j]);
}
struct AL_bf16 { const bf16* A; int lda, pad;
    __device__ __forceinline__ void load4(int row, int k, float* v) const { const ushort4 u = *(const ushort4*)(A + (size_t)row * lda + k); v[0] = bf2f(u.x); v[1] = bf2f(u.y); v[2] = bf2f(u.z); v[3] = bf2f(u.w); } };
struct AL_bf16_gather { const bf16* A; int lda, pad; const int* list;
    __device__ __forceinline__ void load4(int row, int k, float* v) const { const int tok = list[row] >> 1; const ushort4 u = *(const ushort4*)(A + (size_t)tok * lda + k); v[0] = bf2f(u.x); v[1] = bf2f(u.y); v[2] = bf2f(u.z); v[3] = bf2f(u.w); } };
struct BL_plain { const float* B; int ldb, pad;
    __device__ __forceinline__ float4 load4(int k, int n) const { return *(const float4*)(B + (size_t)k * ldb + n); } };
struct BL_rowscale { const float* B; int ldb, pad; const float* g;
    __device__ __forceinline__ float4 load4(int k, int n) const { float4 v = *(const float4*)(B + (size_t)k * ldb + n); const float s = g[k]; v.x *= s; v.y *= s; v.z *= s; v.w *= s; return v; } };

template <class AL, class BL, class EP>
__global__ void __launch_bounds__(256) n_gemm(int M, int K, AL al, BL bl, EP ep) { ngemm_tile(blockIdx.y * 64, blockIdx.x * 64, M, K, al, bl, ep); }

struct EP_proj { bf16* CQ; bf16* CKV; float* KPERAW; bf16* U; bf16* VS;
    __device__ __forceinline__ void operator()(int row, int col, float v) const {
        if (col < QL) CQ[(size_t)row * QL + col] = f2bf(v);
        else if (col < QL + KVL) CKV[(size_t)row * KVL + col - QL] = f2bf(v);
        else if (col < QL + KVL + ROPE) KPERAW[(size_t)row * ROPE + col - QL - KVL] = v;
        else { const int zc = col - (QL + KVL + ROPE); const float g = gelu_tanh(v); if (zc < SGW) U[(size_t)row * SGW + zc] = f2bf(g); else VS[(size_t)row * SGW + zc - SGW] = f2bf(g); }
    } };
__global__ void n_rowstats(const bf16* CQ, const bf16* CKV, const bf16* VS, const float* KPERAW, const float2* cs, float* SSQQ, float* SSQKV, float* VSST, bf16* Kb) {
    const int row = blockIdx.x * 4 + (threadIdx.x >> 6), lane = threadIdx.x & 63, b = row / SEQ, s = row % SEQ;
    float a = 0; for (int i = lane; i < QL; i += 64) { const float v = bf2f(CQ[(size_t)row * QL + i]); a += v * v; } a = wave_sum(a);
    float c = 0; for (int i = lane; i < KVL; i += 64) { const float v = bf2f(CKV[(size_t)row * KVL + i]); c += v * v; } c = wave_sum(c);
    float s1 = 0, s2 = 0; for (int i = lane; i < SGW; i += 64) { const float v = bf2f(VS[(size_t)row * SGW + i]); s1 += v; s2 += v * v; } s1 = wave_sum(s1); s2 = wave_sum(s2);
    if (lane < NPQ) SSQQ[(size_t)row * NPQ + lane] = lane == 0 ? a : 0.f;
    if (lane < NPKV) SSQKV[(size_t)row * NPKV + lane] = lane == 0 ? c : 0.f;
    if (lane < 2 * NPVS) VSST[(size_t)row * 2 * NPVS + lane] = lane == 0 ? s1 : (lane == 1 ? s2 : 0.f);
    if (lane < 32) { const float2 t = cs[row * 32 + lane]; const float x1 = KPERAW[(size_t)row * ROPE + lane], x2 = KPERAW[(size_t)row * ROPE + 32 + lane];
        const bf16 o1 = f2bf(x1 * t.x - x2 * t.y), o2 = f2bf(x2 * t.x + x1 * t.y);
        for (int h = 0; h < NH; ++h) { bf16* kr = Kb + ((size_t)(b * NH + h) * SEQ + s) * QKD + NOPE; kr[lane] = o1; kr[32 + lane] = o2; } }
}
__device__ __forceinline__ float row_total(const float* p, int n) { float s = 0; for (int i = 0; i < n; ++i) s += p[i]; return s; }
struct EP_q { const float* SSQQ; bf16* Q; float* QPERAW;
    __device__ __forceinline__ void operator()(int row, int col, float v) const {
        const float rstd = rsqrtf(row_total(SSQQ + (size_t)row * NPQ, NPQ) * (1.0f / QL) + EPS); v *= rstd;
        const int h = col / QKD, d = col % QKD, b = row / SEQ, s = row % SEQ;
        if (d < NOPE) Q[((size_t)(b * NH + h) * SEQ + s) * QKD + d] = f2bf(v * QSCALE); else QPERAW[((size_t)row * NH + h) * ROPE + d - NOPE] = v;
    } };
__global__ void n_rope_q(const float* QPERAW, const float2* cs, bf16* Q) {
    const int idx = blockIdx.x * 256 + threadIdx.x; if (idx >= NT * NH * 32) return;
    const int i = idx & 31, h = (idx >> 5) & 7, row = idx >> 8, b = row / SEQ, s = row % SEQ;
    const float2 t = cs[row * 32 + i]; const float x1 = QPERAW[((size_t)row * NH + h) * ROPE + i], x2 = QPERAW[((size_t)row * NH + h) * ROPE + 32 + i];
    bf16* qr = Q + ((size_t)(b * NH + h) * SEQ + s) * QKD + NOPE; qr[i] = f2bf((x1 * t.x - x2 * t.y) * QSCALE); qr[32 + i] = f2bf((x2 * t.x + x1 * t.y) * QSCALE);
}
struct EP_kv { const float* SSQKV; bf16* Kb; bf16* Vb;
    __device__ __forceinline__ void operator()(int row, int col, float v) const {
        const float rstd = rsqrtf(row_total(SSQKV + (size_t)row * NPKV, NPKV) * (1.0f / KVL) + EPS); v *= rstd;
        const int h = col >> 8, j = col & 255, b = row / SEQ, s = row % SEQ;
        if (j < NOPE) Kb[((size_t)(b * NH + h) * SEQ + s) * QKD + j] = f2bf(v); else Vb[((size_t)(b * NH + h) * SEQ + s) * VD + j - NOPE] = f2bf(v);
    } };
__global__ void __launch_bounds__(256) n_sgu(const bf16* U, const bf16* VS, const float* VSST, const float* gam, const float* bet, const float* wsp, const float* bsp, bf16* A2) {
    const int bc = blockIdx.x, g = blockIdx.y, row0 = bc * CH, d = threadIdx.x & 127, th = threadIdx.x >> 7;
    __shared__ float mu[CH], rs[CH];
    if (threadIdx.x < CH) { const float* st = VSST + (size_t)(row0 + threadIdx.x) * 2 * NPVS; float s1 = 0, s2 = 0; for (int i = 0; i < NPVS; ++i) { s1 += st[2 * i]; s2 += st[2 * i + 1]; }
        const float m = s1 * (1.0f / SGW); const float var = fmaxf(s2 * (1.0f / SGW) - m * m, 0.f); mu[threadIdx.x] = m; rs[threadIdx.x] = rsqrtf(var + EPS); }
    __syncthreads();
    const int col = g * GD + d; const float ga = gam[col], be = bet[col];
    for (int t = th * 64; t < th * 64 + 64; ++t) { float acc = 0; const float* w = wsp + ((size_t)g * CH + t) * CH;
        for (int s = 0; s <= t; ++s) { const float vn = (bf2f(VS[(size_t)(row0 + s) * SGW + col]) - mu[s]) * rs[s] * ga + be; acc += w[s] * vn; }
        acc += bsp[g * CH + t];
        A2[(size_t)(row0 + t) * D + SGW + col] = f2bf(bf2f(U[(size_t)(row0 + t) * SGW + col]) * acc); }
}
__global__ void __launch_bounds__(256) n_attn(const bf16* Q, const bf16* Kb, const bf16* Vb, bf16* A2) {
    __shared__ float sc[4][SEQ]; __shared__ float qs[4][QKD];
    const int b = blockIdx.z, h = blockIdx.y, w = threadIdx.x >> 6, lane = threadIdx.x & 63;
    const bf16* Kh = Kb + (size_t)(b * NH + h) * SEQ * QKD; const bf16* Vh = Vb + (size_t)(b * NH + h) * SEQ * VD;
    for (int rr = 0; rr < 4; ++rr) { const int qi = blockIdx.x * 16 + w * 4 + rr; const bf16* qrow = Q + ((size_t)(b * NH + h) * SEQ + qi) * QKD;
        for (int i = lane; i < QKD; i += 64) qs[w][i] = bf2f(qrow[i]);
        __builtin_amdgcn_s_waitcnt(0); __builtin_amdgcn_wave_barrier();
        const int nk = qi + 1; float mx = -3.0e38f;
        for (int key = lane; key < nk; key += 64) { const uint4* kr = (const uint4*)(Kh + (size_t)key * QKD); float s = 0;
            for (int c = 0; c < QKD / 8; ++c) { const uint4 u = kr[c]; const unsigned ww[4] = {u.x, u.y, u.z, u.w};
#pragma unroll
                for (int e = 0; e < 4; ++e) { s += qs[w][c * 8 + 2 * e] * __uint_as_float(ww[e] << 16); s += qs[w][c * 8 + 2 * e + 1] * __uint_as_float(ww[e] & 0xffff0000u); } }
            sc[w][key] = s; mx = fmaxf(mx, s); }
        mx = wave_max(mx); float sum = 0;
        for (int key = lane; key < nk; key += 64) { const float p = exp2f(sc[w][key] - mx); sc[w][key] = p; sum += p; }
        sum = wave_sum(sum);
        __builtin_amdgcn_s_waitcnt(0); __builtin_amdgcn_wave_barrier();
        float o0 = 0, o1 = 0;
        for (int key = 0; key < nk; ++key) { const float p = sc[w][key]; const unsigned u = *(const unsigned*)(Vh + (size_t)key * VD + 2 * lane); o0 += p * __uint_as_float(u << 16); o1 += p * __uint_as_float(u & 0xffff0000u); }
        const float inv = 1.0f / sum;
        *(unsigned*)(A2 + (size_t)(b * SEQ + qi) * D + h * VD + 2 * lane) = (unsigned)f2bf(o0 * inv) | ((unsigned)f2bf(o1 * inv) << 16);
        __builtin_amdgcn_s_waitcnt(0); __builtin_amdgcn_wave_barrier();
    }
}
struct EP_wo { const float* x; const float* mod; float* V1;
    __device__ __forceinline__ void operator()(int row, int col, float v) const { const int b = row / SEQ; V1[(size_t)row * D + col] = ALPHA * x[(size_t)row * D + col] + mod[(size_t)b * NMOD + 2 * D + col] * v; } };
__global__ void __launch_bounds__(256) n_mid(float* V1, const float* mod, const float* g1, const float* b1, const float* wrg, const float* brg, const float* wre, const float* bre,
                                             bf16* H2, int* TOKE, float* TOKW, unsigned* cnt, int* LIST) {
    const int row = blockIdx.x * 4 + (threadIdx.x >> 6), lane = threadIdx.x & 63, b = row / SEQ;
    float4* xr = (float4*)(V1 + (size_t)row * D);
    float4 v[8]; float s = 0;
#pragma unroll
    for (int j = 0; j < 8; ++j) { v[j] = xr[j * 64 + lane]; s += v[j].x + v[j].y + v[j].z + v[j].w; }
    float mean = wave_sum(s) * (1.0f / D), q = 0;
#pragma unroll
    for (int j = 0; j < 8; ++j) { v[j].x -= mean; v[j].y -= mean; v[j].z -= mean; v[j].w -= mean; q += v[j].x * v[j].x + v[j].y * v[j].y + v[j].z * v[j].z + v[j].w * v[j].w; }
    float rstd = rsqrtf(wave_sum(q) * (1.0f / D) + EPS); s = 0;
#pragma unroll
    for (int j = 0; j < 8; ++j) { const float4 g = ((const float4*)g1)[j * 64 + lane], bb = ((const float4*)b1)[j * 64 + lane];
        v[j].x = v[j].x * rstd * g.x + bb.x; v[j].y = v[j].y * rstd * g.y + bb.y; v[j].z = v[j].z * rstd * g.z + bb.z; v[j].w = v[j].w * rstd * g.w + bb.w;
        xr[j * 64 + lane] = v[j]; s += v[j].x + v[j].y + v[j].z + v[j].w; }
    mean = wave_sum(s) * (1.0f / D); q = 0;
#pragma unroll
    for (int j = 0; j < 8; ++j) { v[j].x -= mean; v[j].y -= mean; v[j].z -= mean; v[j].w -= mean; q += v[j].x * v[j].x + v[j].y * v[j].y + v[j].z * v[j].z + v[j].w * v[j].w; }
    rstd = rsqrtf(wave_sum(q) * (1.0f / D) + EPS);
    const float4* sh = (const float4*)(mod + (size_t)b * NMOD + 3 * D); const float4* sc = (const float4*)(mod + (size_t)b * NMOD + 4 * D);
    float lg[36];
#pragma unroll
    for (int i = 0; i < 36; ++i) lg[i] = 0.f;
#pragma unroll
    for (int j = 0; j < 8; ++j) { const float4 a = sh[j * 64 + lane], m = sc[j * 64 + lane];
        float hv[4] = {v[j].x * rstd * (1.f + m.x) + a.x, v[j].y * rstd * (1.f + m.y) + a.y, v[j].z * rstd * (1.f + m.z) + a.z, v[j].w * rstd * (1.f + m.w) + a.w};
        ushort4 o; o.x = f2bf(hv[0]); o.y = f2bf(hv[1]); o.z = f2bf(hv[2]); o.w = f2bf(hv[3]);
        *(ushort4*)(H2 + (size_t)row * D + (j * 64 + lane) * 4) = o;
#pragma unroll
        for (int e = 0; e < 4; ++e) { const int col = (j * 64 + lane) * 4 + e; const float hh = hv[e];
            const float4 wg = *(const float4*)(wrg + (size_t)col * 4); lg[0] += hh * wg.x; lg[1] += hh * wg.y; lg[2] += hh * wg.z; lg[3] += hh * wg.w;
#pragma unroll
            for (int c = 0; c < 8; ++c) { const float4 we = *(const float4*)(wre + (size_t)col * 32 + c * 4); lg[4 + c * 4] += hh * we.x; lg[5 + c * 4] += hh * we.y; lg[6 + c * 4] += hh * we.z; lg[7 + c * 4] += hh * we.w; } } }
#pragma unroll
    for (int i = 0; i < 36; ++i) lg[i] = wave_sum(lg[i]);
    if (lane == 0) {
        float best = lg[0] + brg[0]; int gi = 0;
#pragma unroll
        for (int i = 1; i < 4; ++i) { const float t = lg[i] + brg[i]; if (t > best) { best = t; gi = i; } }
        float den = 0;
#pragma unroll
        for (int i = 0; i < 4; ++i) den += expf(lg[i] + brg[i] - best);
        const float pg = 1.0f / den;
        float le[8];
#pragma unroll
        for (int i = 0; i < 8; ++i) { float t = 0.f;
#pragma unroll
            for (int g = 0; g < 4; ++g) { const float cand = lg[4 + g * 8 + i] + bre[g * 8 + i]; t = (gi == g) ? cand : t; }
            le[i] = t; }
        float v1 = le[0]; int i1 = 0;
#pragma unroll
        for (int i = 1; i < 8; ++i) if (le[i] > v1) { v1 = le[i]; i1 = i; }
        float v2 = -3.0e38f; int i2 = 0;
#pragma unroll
        for (int i = 0; i < 8; ++i) if (i != i1 && le[i] > v2) { v2 = le[i]; i2 = i; }
        const float w1 = 1.0f / (1.0f + expf(v2 - v1)), w2 = 1.0f - w1;
        const int e1 = gi * 8 + i1, e2 = gi * 8 + i2;
        TOKE[row * 2] = e1; TOKE[row * 2 + 1] = e2; TOKW[row * 2] = pg * w1; TOKW[row * 2 + 1] = pg * w2;
        const unsigned p1 = atomicAdd(cnt + e1, 1u); LIST[e1 * NT + p1] = row * 2;
        const unsigned p2 = atomicAdd(cnt + e2, 1u); LIST[e2 * NT + p2] = row * 2 + 1;
    }
}
__device__ __forceinline__ int expert_base(const unsigned* cnt, int e) { int b = 0; for (int i = 0; i < e; ++i) b += ((int)cnt[i] + 255) / 256 * 256; return b; }
__global__ void __launch_bounds__(256) n_moe_gu(const bf16* H2, const float* wg, const float* wu, const unsigned* cnt, const int* LIST, float* G, bf16* HID, int pass) {
    const int e = blockIdx.z, M = (int)cnt[e], m0 = blockIdx.y * 64; if (m0 >= M) return;
    const int base = expert_base(cnt, e);
    AL_bf16_gather al{H2, D, 0, LIST + (size_t)e * NT};
    if (pass == 0) { BL_plain bl{wg + (size_t)e * D * FF, FF, 0}; float* Gp = G + (size_t)base * FF;
        auto ep = [=](int row, int col, float v) { Gp[(size_t)row * FF + col] = v; }; ngemm_tile(m0, blockIdx.x * 64, M, D, al, bl, ep); }
    else { BL_plain bl{wu + (size_t)e * D * FF, FF, 0}; const float* Gp = G + (size_t)base * FF; bf16* Hp = HID + (size_t)base * FF;
        auto ep = [=](int row, int col, float v) { const float g = Gp[(size_t)row * FF + col]; Hp[(size_t)row * FF + col] = f2bf(g / (1.0f + expf(-g)) * v); }; ngemm_tile(m0, blockIdx.x * 64, M, D, al, bl, ep); }
}
__global__ void __launch_bounds__(256) n_moe_dn(const bf16* HID, const float* wd, const unsigned* cnt, const int* LIST, const float* TOKW, bf16* Y2) {
    const int e = blockIdx.z, M = (int)cnt[e], m0 = blockIdx.y * 64; if (m0 >= M) return;
    const int base = expert_base(cnt, e);
    AL_bf16 al{HID + (size_t)base * FF, FF, 0}; BL_plain bl{wd + (size_t)e * FF * D, D, 0}; const int* lst = LIST + (size_t)e * NT;
    auto ep = [=](int row, int col, float v) { const int t2 = lst[row]; Y2[(size_t)t2 * D + col] = f2bf(TOKW[t2] * v); };
    ngemm_tile(m0, blockIdx.x * 64, M, FF, al, bl, ep);
}
__global__ void __launch_bounds__(256) n_final(float* X1, const bf16* Y2, const float* mod, const float* g2l, const float* b2l) {
    const int row = blockIdx.x * 4 + (threadIdx.x >> 6), lane = threadIdx.x & 63, b = row / SEQ;
    float4* xr = (float4*)(X1 + (size_t)row * D); const float4* gt = (const float4*)(mod + (size_t)b * NMOD + 5 * D);
    float4 v[8]; float s = 0;
#pragma unroll
    for (int j = 0; j < 8; ++j) { const float4 x = xr[j * 64 + lane], g = gt[j * 64 + lane];
        const ushort4 ya = *(const ushort4*)(Y2 + (size_t)(row * 2) * D + (j * 64 + lane) * 4), yb = *(const ushort4*)(Y2 + (size_t)(row * 2 + 1) * D + (j * 64 + lane) * 4);
        v[j].x = ALPHA * x.x + g.x * (bf2f(ya.x) + bf2f(yb.x)); v[j].y = ALPHA * x.y + g.y * (bf2f(ya.y) + bf2f(yb.y)); v[j].z = ALPHA * x.z + g.z * (bf2f(ya.z) + bf2f(yb.z)); v[j].w = ALPHA * x.w + g.w * (bf2f(ya.w) + bf2f(yb.w));
        s += v[j].x + v[j].y + v[j].z + v[j].w; }
    const float mean = wave_sum(s) * (1.0f / D); float q = 0;
#pragma unroll
    for (int j = 0; j < 8; ++j) { v[j].x -= mean; v[j].y -= mean; v[j].z -= mean; v[j].w -= mean; q += v[j].x * v[j].x + v[j].y * v[j].y + v[j].z * v[j].z + v[j].w * v[j].w; }
    const float rstd = rsqrtf(wave_sum(q) * (1.0f / D) + EPS);
#pragma unroll
    for (int j = 0; j < 8; ++j) { const float4 g = ((const float4*)g2l)[j * 64 + lane], bb = ((const float4*)b2l)[j * 64 + lane];
        float4 o; o.x = v[j].x * rstd * g.x + bb.x; o.y = v[j].y * rstd * g.y + bb.y; o.z = v[j].z * rstd * g.z + bb.z; o.w = v[j].w * rstd * g.w + bb.w; xr[j * 64 + lane] = o; }
}

extern "C" void kernel_launch(void* const* d_in, const int* in_sizes, int n_in, void* d_out, int out_size, void* d_ws, size_t ws_size, hipStream_t stream) {
    if (n_in != 26 || out_size != NT * D || ws_size < WS_END) { fprintf(stderr, "kernel_launch: unexpected shapes (n_in %d out %d ws %zu)\n", n_in, out_size, ws_size); return; }
    const float* x = (const float*)d_in[0]; const float* c = (const float*)d_in[1]; const int* positions = (const int*)d_in[2];
    const float* w_ada = (const float*)d_in[3]; const float* b_ada = (const float*)d_in[4]; const float* w_in = (const float*)d_in[5];
    const float* q_norm_g = (const float*)d_in[6]; const float* w_uq = (const float*)d_in[7]; const float* kv_norm_g = (const float*)d_in[8]; const float* w_ukv = (const float*)d_in[9];
    const float* sgu_g = (const float*)d_in[10]; const float* sgu_b = (const float*)d_in[11]; const float* w_sp = (const float*)d_in[12]; const float* b_sp = (const float*)d_in[13];
    const float* w_o = (const float*)d_in[14]; const float* ln1_g = (const float*)d_in[15]; const float* ln1_b = (const float*)d_in[16];
    const float* wrg = (const float*)d_in[17]; const float* brg = (const float*)d_in[18]; const float* wre = (const float*)d_in[19]; const float* bre = (const float*)d_in[20];
    const float* w_gate = (const float*)d_in[21]; const float* w_up = (const float*)d_in[22]; const float* w_down = (const float*)d_in[23];
    const float* ln2_g = (const float*)d_in[24]; const float* ln2_b = (const float*)d_in[25];
    unsigned char* ws = (unsigned char*)d_ws; float* out = (float*)d_out;
    float* MOD = (float*)(ws + WS_MOD); float2* RT = (float2*)(ws + WS_ROPE); float* SSQQ = (float*)(ws + WS_SSQQ); float* SSQKV = (float*)(ws + WS_SSQKV); float* VSST = (float*)(ws + WS_VSST);
    int* TOKE = (int*)(ws + WS_TOKE); float* TOKW = (float*)(ws + WS_TOKW); int* LIST = (int*)(ws + WS_LIST); unsigned* cnt = (unsigned*)(ws + WS_CTL) + CW_CNT;
    bf16* H = (bf16*)(ws + WS_H); bf16* CQ = (bf16*)(ws + WS_CQ); bf16* CKV = (bf16*)(ws + WS_CKV); bf16* U = (bf16*)(ws + WS_U); bf16* VS = (bf16*)(ws + WS_VS);
    bf16* Qb = (bf16*)(ws + WS_Q); bf16* Kb = (bf16*)(ws + WS_K); bf16* Vb = (bf16*)(ws + WS_V); bf16* A2 = (bf16*)(ws + WS_A2); bf16* HID = (bf16*)(ws + WS_HID); bf16* Y2 = (bf16*)(ws + WS_Y2);
    float* KPERAW = (float*)(ws + WS_KPERAW); float* QPERAW = (float*)(ws + WS_QPERAW); float* G = (float*)(ws + WS_G);

    (void)hipMemsetAsync(ws + WS_CTL, 0, CTL_BYTES, stream);
    n_mod<<<NMOD / 256, 256, 0, stream>>>(c, w_ada, b_ada, MOD);
    n_rope_table<<<NT * 32 / 256, 256, 0, stream>>>(positions, RT);
    n_ln_mod<<<NT / 4, 256, 0, stream>>>(x, MOD, 0, D, H);
    n_gemm<<<dim3(INP / 64, NT / 64), 256, 0, stream>>>(NT, D, AL_bf16{H, D, 0}, BL_plain{w_in, INP, 0}, EP_proj{CQ, CKV, KPERAW, U, VS});
    n_rowstats<<<NT / 4, 256, 0, stream>>>(CQ, CKV, VS, KPERAW, RT, SSQQ, SSQKV, VSST, Kb);
    n_gemm<<<dim3(NH * QKD / 64, NT / 64), 256, 0, stream>>>(NT, QL, AL_bf16{CQ, QL, 0}, BL_rowscale{w_uq, NH * QKD, 0, q_norm_g}, EP_q{SSQQ, Qb, QPERAW});
    n_rope_q<<<NT * NH * 32 / 256, 256, 0, stream>>>(QPERAW, RT, Qb);
    n_gemm<<<dim3(NH * 256 / 64, NT / 64), 256, 0, stream>>>(NT, KVL, AL_bf16{CKV, KVL, 0}, BL_rowscale{w_ukv, NH * 256, 0, kv_norm_g}, EP_kv{SSQKV, Kb, Vb});
    n_sgu<<<dim3(NT / CH, NG), 256, 0, stream>>>(U, VS, VSST, sgu_g, sgu_b, w_sp, b_sp, A2);
    n_attn<<<dim3(SEQ / 16, NH, NB), 256, 0, stream>>>(Qb, Kb, Vb, A2);
    n_gemm<<<dim3(D / 64, NT / 64), 256, 0, stream>>>(NT, D, AL_bf16{A2, D, 0}, BL_plain{w_o, D, 0}, EP_wo{x, MOD, out});
    n_mid<<<NT / 4, 256, 0, stream>>>(out, MOD, ln1_g, ln1_b, wrg, brg, wre, bre, H, TOKE, TOKW, cnt, LIST);
    n_moe_gu<<<dim3(FF / 64, NT / 64, NE), 256, 0, stream>>>(H, w_gate, w_up, cnt, LIST, G, HID, 0);
    n_moe_gu<<<dim3(FF / 64, NT / 64, NE), 256, 0, stream>>>(H, w_gate, w_up, cnt, LIST, G, HID, 1);
    n_moe_dn<<<dim3(D / 64, NT / 64, NE), 256, 0, stream>>>(HID, w_down, cnt, LIST, TOKW, Y2);
    n_final<<<NT / 4, 256, 0, stream>>>(out, Y2, MOD, ln2_g, ln2_b);
}
```

```cpp
#include <hip/hip_runtime.h>
#include <cstdio>
#include <cstdint>

constexpr int NB = 4, SEQ = 2048, NT = NB * SEQ, D = 2048;
constexpr int QL = 768, KVL = 512, ROPE = 64, NOPE = 128, VD = 128, NH = 8, QKD = NOPE + ROPE;
constexpr int SGW = 1024, NG = 8, GD = 128, CH = 128;
constexpr int INP = QL + KVL + ROPE + 2 * SGW;
constexpr int NE = 32, EPG = 8, NGRP = 4, FF = 512;
constexpr int NMOD = 6 * D;
constexpr float EPS = 1e-6f;
constexpr float ALPHA = 1.189207115002721f;
constexpr float QSCALE = 0.07216878364870323f * 1.4426950408889634f;
constexpr int NPQ = 12, NPKV = 8, NPVS = 16;
constexpr int HIDROWS = 24576;

constexpr size_t MiB = 1u << 20;
constexpr size_t WS_CTL = 0, CTL_BYTES = 1 * MiB;
constexpr size_t WS_MOD = 1 * MiB, WS_ROPE = 2 * MiB, WS_SSQQ = 4 * MiB, WS_SSQKV = 5 * MiB, WS_VSST = 6 * MiB, WS_TOKE = 7 * MiB, WS_TOKW = 7 * MiB + 512 * 1024, WS_LIST = 8 * MiB;
constexpr size_t WS_WIN = 10 * MiB, WS_WUQ = 24 * MiB, WS_WUKV = 27 * MiB, WS_WO = 29 * MiB, WS_WGU = 37 * MiB, WS_WDN = 165 * MiB, WS_WSP = 229 * MiB, WS_WR = 230 * MiB;
constexpr size_t WS_H = 231 * MiB, WS_CQ = 263 * MiB, WS_CKV = 275 * MiB, WS_U = 283 * MiB, WS_VS = 299 * MiB, WS_Q = 315 * MiB, WS_K = 339 * MiB, WS_V = 363 * MiB;
constexpr size_t WS_A2 = 379 * MiB, WS_HID = 411 * MiB, WS_Y2 = 435 * MiB, WS_END = 499 * MiB;
constexpr size_t WS_KPERAW = WS_Y2, WS_QPERAW = WS_Y2 + 2 * MiB, WS_G = WS_Q;
constexpr int CW_CNT = 1024;

typedef unsigned short bf16;
__device__ __forceinline__ bf16 f2bf(float f) { unsigned u = __float_as_uint(f); u += 0x7fffu + ((u >> 16) & 1u); return (bf16)(u >> 16); }
__device__ __forceinline__ float bf2f(bf16 b) { return __uint_as_float(((unsigned)b) << 16); }
__device__ __forceinline__ float wave_sum(float v) {
#pragma unroll
    for (int o = 1; o < 64; o <<= 1) v += __shfl_xor(v, o);
    return v;
}
__device__ __forceinline__ float wave_max(float v) {
#pragma unroll
    for (int o = 1; o < 64; o <<= 1) v = fmaxf(v, __shfl_xor(v, o));
    return v;
}
__device__ __forceinline__ float gelu_tanh(float x) { const float u = 0.7978845608028654f * (x + 0.044715f * x * x * x); return 0.5f * x * (1.0f + tanhf(u)); }

__global__ void n_mod(const float* c, const float* w_ada, const float* b_ada, float* mod) {
    const int j = blockIdx.x * 256 + threadIdx.x;
    float a0 = 0, a1 = 0, a2 = 0, a3 = 0;
    for (int k = 0; k < D; ++k) { const float w = w_ada[(size_t)k * NMOD + j]; a0 += c[k] * w; a1 += c[D + k] * w; a2 += c[2 * D + k] * w; a3 += c[3 * D + k] * w; }
    const float bb = b_ada[j];
    mod[j] = a0 + bb; mod[NMOD + j] = a1 + bb; mod[2 * NMOD + j] = a2 + bb; mod[3 * NMOD + j] = a3 + bb;
}
__global__ void n_rope_table(const int* positions, float2* cs) {
    const int idx = blockIdx.x * 256 + threadIdx.x; if (idx >= NT * 32) return;
    const int tok = idx >> 5, i = idx & 31;
    const float inv = 1.0f / powf(10000.0f, (float)(2 * i) / 64.0f);
    const float ang = (float)positions[tok] * inv;
    cs[idx] = make_float2((float)cos((double)ang), (float)sin((double)ang));
}
__global__ void n_ln_mod(const float* x, const float* mod, int sh_off, int sc_off, bf16* out) {
    const int row = blockIdx.x * 4 + (threadIdx.x >> 6), lane = threadIdx.x & 63, b = row / SEQ;
    const float4* xr = (const float4*)(x + (size_t)row * D);
    float4 v[8]; float s = 0;
#pragma unroll
    for (int j = 0; j < 8; ++j) { v[j] = xr[j * 64 + lane]; s += v[j].x + v[j].y + v[j].z + v[j].w; }
    const float mean = wave_sum(s) * (1.0f / D); float q = 0;
#pragma unroll
    for (int j = 0; j < 8; ++j) { v[j].x -= mean; v[j].y -= mean; v[j].z -= mean; v[j].w -= mean; q += v[j].x * v[j].x + v[j].y * v[j].y + v[j].z * v[j].z + v[j].w * v[j].w; }
    const float rstd = rsqrtf(wave_sum(q) * (1.0f / D) + EPS);
    const float4* sh = (const float4*)(mod + (size_t)b * NMOD + sh_off); const float4* sc = (const float4*)(mod + (size_t)b * NMOD + sc_off);
#pragma unroll
    for (int j = 0; j < 8; ++j) { const float4 a = sh[j * 64 + lane], m = sc[j * 64 + lane];
        ushort4 o; o.x = f2bf(v[j].x * rstd * (1.f + m.x) + a.x); o.y = f2bf(v[j].y * rstd * (1.f + m.y) + a.y); o.z = f2bf(v[j].z * rstd * (1.f + m.z) + a.z); o.w = f2bf(v[j].w * rstd * (1.f + m.w) + a.w);
        *(ushort4*)(out + (size_t)row * D + (j * 64 + lane) * 4) = o; }
}

template <class AL, class BL, class EP>
__device__ __forceinline__ void ngemm_tile(int m0, int n0, int M, int K, const AL& al, const BL& bl, const EP& ep) {
    __shared__ float As[16][65]; __shared__ float Bs[16][64];
    const int t = threadIdx.x, tx = t & 15, ty = t >> 4;
    float acc[4][4];
#pragma unroll
    for (int i = 0; i < 4; ++i)
#pragma unroll
        for (int j = 0; j < 4; ++j) acc[i][j] = 0.f;
    for (int k0 = 0; k0 < K; k0 += 16) {
        { const int r = t >> 2, kq = (t & 3) * 4; float v[4] = {0.f, 0.f, 0.f, 0.f}; if (m0 + r < M) al.load4(m0 + r, k0 + kq, v);
          As[kq + 0][r] = v[0]; As[kq + 1][r] = v[1]; As[kq + 2][r] = v[2]; As[kq + 3][r] = v[3]; }
        { const int kk = t >> 4, nq = (t & 15) * 4; const float4 v = bl.load4(k0 + kk, n0 + nq); *(float4*)&Bs[kk][nq] = v; }
        __syncthreads();
#pragma unroll
        for (int kk = 0; kk < 16; ++kk) { float a[4], b[4];
#pragma unroll
            for (int i = 0; i < 4; ++i) a[i] = As[kk][ty * 4 + i];
            const float4 bv = *(const float4*)&Bs[kk][tx * 4]; b[0] = bv.x; b[1] = bv.y; b[2] = bv.z; b[3] = bv.w;
#pragma unroll
            for (int i = 0; i < 4; ++i)
#pragma unroll
                for (int j = 0; j < 4; ++j) acc[i][j] += a[i] * b[j]; }
        __syncthreads();
    }
#pragma unroll
    for (int i = 0; i < 4; ++i)
#pragma unroll
        for (int j = 0; j < 4; ++j) if (m0 + ty * 4 + i < M) ep(m0 + ty * 4 + i, n0 + tx * 4 + j, acc[i][j]);
}
struct AL_bf16 { const bf16* A; int lda, pad;
    __device__ __forceinline__ void load4(int row, int k, float* v) const { const ushort4 u = *(const ushort4*)(A + (size_t)row * lda + k); v[0] = bf2f(u.x); v[1] = bf2f(u.y); v[2] = bf2f(u.z); v[3] = bf2f(u.w); } };
struct AL_bf16_gather { const bf16* A; int lda, pad; const int* list;
    __device__ __forceinline__ void load4(int row, int k, float* v) const { const int tok = list[row] >> 1; const ushort4 u = *(const ushort4*)(A + (size_t)tok * lda + k); v[0] = bf2f(u.x); v[1] = bf2f(u.y); v[2] = bf2f(u.z); v[3] = bf2f(u.w); } };
struct BL_plain { const float* B; int ldb, pad;
    __device__ __forceinline__ float4 load4(int k, int n) const { return *(const float4*)(B + (size_t)k * ldb + n); } };
struct BL_rowscale { const float* B; int ldb, pad; const float* g;
    __device__ __forceinline__ float4 load4(int k, int n) const { float4 v = *(const float4*)(B + (size_t)k * ldb + n); const float s = g[k]; v.x *= s; v.y *= s; v.z *= s; v.w *= s; return v; } };

template <class AL, class BL, class EP>
__global__ void __launch_bounds__(256) n_gemm(int M, int K, AL al, BL bl, EP ep) { ngemm_tile(blockIdx.y * 64, blockIdx.x * 64, M, K, al, bl, ep); }

struct EP_proj { bf16* CQ; bf16* CKV; float* KPERAW; bf16* U; bf16* VS;
    __device__ __forceinline__ void operator()(int row, int col, float v) const {
        if (col < QL) CQ[(size_t)row * QL + col] = f2bf(v);
        else if (col < QL + KVL) CKV[(size_t)row * KVL + col - QL] = f2bf(v);
        else if (col < QL + KVL + ROPE) KPERAW[(size_t)row * ROPE + col - QL - KVL] = v;
        else { const int zc = col - (QL + KVL + ROPE); const float g = gelu_tanh(v); if (zc < SGW) U[(size_t)row * SGW + zc] = f2bf(g); else VS[(size_t)row * SGW + zc - SGW] = f2bf(g); }
    } };
__global__ void n_rowstats(const bf16* CQ, const bf16* CKV, const bf16* VS, const float* KPERAW, const float2* cs, float* SSQQ, float* SSQKV, float* VSST, bf16* Kb) {
    const int row = blockIdx.x * 4 + (threadIdx.x >> 6), lane = threadIdx.x & 63, b = row / SEQ, s = row % SEQ;
    float a = 0; for (int i = lane; i < QL; i += 64) { const float v = bf2f(CQ[(size_t)row * QL + i]); a += v * v; } a = wave_sum(a);
    float c = 0; for (int i = lane; i < KVL; i += 64) { const float v = bf2f(CKV[(size_t)row * KVL + i]); c += v * v; } c = wave_sum(c);
    float s1 = 0, s2 = 0; for (int i = lane; i < SGW; i += 64) { const float v = bf2f(VS[(size_t)row * SGW + i]); s1 += v; s2 += v * v; } s1 = wave_sum(s1); s2 = wave_sum(s2);
    if (lane < NPQ) SSQQ[(size_t)row * NPQ + lane] = lane == 0 ? a : 0.f;
    if (lane < NPKV) SSQKV[(size_t)row * NPKV + lane] = lane == 0 ? c : 0.f;
    if (lane < 2 * NPVS) VSST[(size_t)row * 2 * NPVS + lane] = lane == 0 ? s1 : (lane == 1 ? s2 : 0.f);
    if (lane < 32) { const float2 t = cs[row * 32 + lane]; const float x1 = KPERAW[(size_t)row * ROPE + lane], x2 = KPERAW[(size_t)row * ROPE + 32 + lane];
        const bf16 o1 = f2bf(x1 * t.x - x2 * t.y), o2 = f2bf(x2 * t.x + x1 * t.y);
        for (int h = 0; h < NH; ++h) { bf16* kr = Kb + ((size_t)(b * NH + h) * SEQ + s) * QKD + NOPE; kr[lane] = o1; kr[32 + lane] = o2; } }
}
__device__ __forceinline__ float row_total(const float* p, int n) { float s = 0; for (int i = 0; i < n; ++i) s += p[i]; return s; }
struct EP_q { const float* SSQQ; bf16* Q; float* QPERAW;
    __device__ __forceinline__ void operator()(int row, int col, float v) const {
        const float rstd = rsqrtf(row_total(SSQQ + (size_t)row * NPQ, NPQ) * (1.0f / QL) + EPS); v *= rstd;
        const int h = col / QKD, d = col % QKD, b = row / SEQ, s = row % SEQ;
        if (d < NOPE) Q[((size_t)(b * NH + h) * SEQ + s) * QKD + d] = f2bf(v * QSCALE); else QPERAW[((size_t)row * NH + h) * ROPE + d - NOPE] = v;
    } };
__global__ void n_rope_q(const float* QPERAW, const float2* cs, bf16* Q) {
    const int idx = blockIdx.x * 256 + threadIdx.x; if (idx >= NT * NH * 32) return;
    const int i = idx & 31, h = (idx >> 5) & 7, row = idx >> 8, b = row / SEQ, s = row % SEQ;
    const float2 t = cs[row * 32 + i]; const float x1 = QPERAW[((size_t)row * NH + h) * ROPE + i], x2 = QPERAW[((size_t)row * NH + h) * ROPE + 32 + i];
    bf16* qr = Q + ((size_t)(b * NH + h) * SEQ + s) * QKD + NOPE; qr[i] = f2bf((x1 * t.x - x2 * t.y) * QSCALE); qr[32 + i] = f2bf((x2 * t.x + x1 * t.y) * QSCALE);
}
struct EP_kv { const float* SSQKV; bf16* Kb; bf16* Vb;
    __device__ __forceinline__ void operator()(int row, int col, float v) const {
        const float rstd = rsqrtf(row_total(SSQKV + (size_t)row * NPKV, NPKV) * (1.0f / KVL) + EPS); v *= rstd;
        const int h = col >> 8, j = col & 255, b = row / SEQ, s = row % SEQ;
        if (j < NOPE) Kb[((size_t)(b * NH + h) * SEQ + s) * QKD + j] = f2bf(v); else Vb[((size_t)(b * NH + h) * SEQ + s) * VD + j - NOPE] = f2bf(v);
    } };
__global__ void __launch_bounds__(256) n_sgu(const bf16* U, const bf16* VS, const float* VSST, const float* gam, const float* bet, const float* wsp, const float* bsp, bf16* A2) {
    const int bc = blockIdx.x, g = blockIdx.y, row0 = bc * CH, d = threadIdx.x & 127, th = threadIdx.x >> 7;
    __shared__ float mu[CH], rs[CH];
    if (threadIdx.x < CH) { const float* st = VSST + (size_t)(row0 + threadIdx.x) * 2 * NPVS; float s1 = 0, s2 = 0; for (int i = 0; i < NPVS; ++i) { s1 += st[2 * i]; s2 += st[2 * i + 1]; }
        const float m = s1 * (1.0f / SGW); const float var = fmaxf(s2 * (1.0f / SGW) - m * m, 0.f); mu[threadIdx.x] = m; rs[threadIdx.x] = rsqrtf(var + EPS); }
    __syncthreads();
    const int col = g * GD + d; const float ga = gam[col], be = bet[col];
    for (int t = th * 64; t < th * 64 + 64; ++t) { float acc = 0; const float* w = wsp + ((size_t)g * CH + t) * CH;
        for (int s = 0; s <= t; ++s) { const float vn = (bf2f(VS[(size_t)(row0 + s) * SGW + col]) - mu[s]) * rs[s] * ga + be; acc += w[s] * vn; }
        acc += bsp[g * CH + t];
        A2[(size_t)(row0 + t) * D + SGW + col] = f2bf(bf2f(U[(size_t)(row0 + t) * SGW + col]) * acc); }
}
__global__ void __launch_bounds__(256) n_attn(const bf16* Q, const bf16* Kb, const bf16* Vb, bf16* A2) {
    __shared__ float sc[4][SEQ]; __shared__ float qs[4][QKD];
    const int b = blockIdx.z, h = blockIdx.y, w = threadIdx.x >> 6, lane = threadIdx.x & 63;
    const bf16* Kh = Kb + (size_t)(b * NH + h) * SEQ * QKD; const bf16* Vh = Vb + (size_t)(b * NH + h) * SEQ * VD;
    for (int rr = 0; rr < 4; ++rr) { const int qi = blockIdx.x * 16 + w * 4 + rr; const bf16* qrow = Q + ((size_t)(b * NH + h) * SEQ + qi) * QKD;
        for (int i = lane; i < QKD; i += 64) qs[w][i] = bf2f(qrow[i]);
        __builtin_amdgcn_s_waitcnt(0); __builtin_amdgcn_wave_barrier();
        const int nk = qi + 1; float mx = -3.0e38f;
        for (int key = lane; key < nk; key += 64) { const uint4* kr = (const uint4*)(Kh + (size_t)key * QKD); float s = 0;
            for (int c = 0; c < QKD / 8; ++c) { const uint4 u = kr[c]; const unsigned ww[4] = {u.x, u.y, u.z, u.w};
#pragma unroll
                for (int e = 0; e < 4; ++e) { s += qs[w][c * 8 + 2 * e] * __uint_as_float(ww[e] << 16); s += qs[w][c * 8 + 2 * e + 1] * __uint_as_float(ww[e] & 0xffff0000u); } }
            sc[w][key] = s; mx = fmaxf(mx, s); }
        mx = wave_max(mx); float sum = 0;
        for (int key = lane; key < nk; key += 64) { const float p = exp2f(sc[w][key] - mx); sc[w][key] = p; sum += p; }
        sum = wave_sum(sum);
        __builtin_amdgcn_s_waitcnt(0); __builtin_amdgcn_wave_barrier();
        float o0 = 0, o1 = 0;
        for (int key = 0; key < nk; ++key) { const float p = sc[w][key]; const unsigned u = *(const unsigned*)(Vh + (size_t)key * VD + 2 * lane); o0 += p * __uint_as_float(u << 16); o1 += p * __uint_as_float(u & 0xffff0000u); }
        const float inv = 1.0f / sum;
        *(unsigned*)(A2 + (size_t)(b * SEQ + qi) * D + h * VD + 2 * lane) = (unsigned)f2bf(o0 * inv) | ((unsigned)f2bf(o1 * inv) << 16);
        __builtin_amdgcn_s_waitcnt(0); __builtin_amdgcn_wave_barrier();
    }
}
struct EP_wo { const float* x; const float* mod; float* V1;
    __device__ __forceinline__ void operator()(int row, int col, float v) const { const int b = row / SEQ; V1[(size_t)row * D + col] = ALPHA * x[(size_t)row * D + col] + mod[(size_t)b * NMOD + 2 * D + col] * v; } };
__global__ void __launch_bounds__(256) n_mid(float* V1, const float* mod, const float* g1, const float* b1, const float* wrg, const float* brg, const float* wre, const float* bre,
                                             bf16* H2, int* TOKE, float* TOKW, unsigned* cnt, int* LIST) {
    const int row = blockIdx.x * 4 + (threadIdx.x >> 6), lane = threadIdx.x & 63, b = row / SEQ;
    float4* xr = (float4*)(V1 + (size_t)row * D);
    float4 v[8]; float s = 0;
#pragma unroll
    for (int j = 0; j < 8; ++j) { v[j] = xr[j * 64 + lane]; s += v[j].x + v[j].y + v[j].z + v[j].w; }
    float mean = wave_sum(s) * (1.0f / D), q = 0;
#pragma unroll
    for (int j = 0; j < 8; ++j) { v[j].x -= mean; v[j].y -= mean; v[j].z -= mean; v[j].w -= mean; q += v[j].x * v[j].x + v[j].y * v[j].y + v[j].z * v[j].z + v[j].w * v[j].w; }
    float rstd = rsqrtf(wave_sum(q) * (1.0f / D) + EPS); s = 0;
#pragma unroll
    for (int j = 0; j < 8; ++j) { const float4 g = ((const float4*)g1)[j * 64 + lane], bb = ((const float4*)b1)[j * 64 + lane];
        v[j].x = v[j].x * rstd * g.x + bb.x; v[j].y = v[j].y * rstd * g.y + bb.y; v[j].z = v[j].z * rstd * g.z + bb.z; v[j].w = v[j].w * rstd * g.w + bb.w;
        xr[j * 64 + lane] = v[j]; s += v[j].x + v[j].y + v[j].z + v[j].w; }
    mean = wave_sum(s) * (1.0f / D); q = 0;
#pragma unroll
    for (int j = 0; j < 8; ++j) { v[j].x -= mean; v[j].y -= mean; v[j].z -= mean; v[j].w -= mean; q += v[j].x * v[j].x + v[j].y * v[j].y + v[j].z * v[j].z + v[j].w * v[j].w; }
    rstd = rsqrtf(wave_sum(q) * (1.0f / D) + EPS);
    const float4* sh = (const float4*)(mod + (size_t)b * NMOD + 3 * D); const float4* sc = (const float4*)(mod + (size_t)b * NMOD + 4 * D);
    float lg[36];
#pragma unroll
    for (int i = 0; i < 36; ++i) lg[i] = 0.f;
#pragma unroll
    for (int j = 0; j < 8; ++j) { const float4 a = sh[j * 64 + lane], m = sc[j * 64 + lane];
        float hv[4] = {v[j].x * rstd * (1.f + m.x) + a.x, v[j].y * rstd * (1.f + m.y) + a.y, v[j].z * rstd * (1.f + m.z) + a.z, v[j].w * rstd * (1.f + m.w) + a.w};
        ushort4 o; o.x = f2bf(hv[0]); o.y = f2bf(hv[1]); o.z = f2bf(hv[2]); o.w = f2bf(hv[3]);
        *(ushort4*)(H2 + (size_t)row * D + (j * 64 + lane) * 4) = o;
#pragma unroll
        for (int e = 0; e < 4; ++e) { const int col = (j * 64 + lane) * 4 + e; const float hh = hv[e];
            const float4 wg = *(const float4*)(wrg + (size_t)col * 4); lg[0] += hh * wg.x; lg[1] += hh * wg.y; lg[2] += hh * wg.z; lg[3] += hh * wg.w;
#pragma unroll
            for (int c = 0; c < 8; ++c) { const float4 we = *(const float4*)(wre + (size_t)col * 32 + c * 4); lg[4 + c * 4] += hh * we.x; lg[5 + c * 4] += hh * we.y; lg[6 + c * 4] += hh * we.z; lg[7 + c * 4] += hh * we.w; } } }
#pragma unroll
    for (int i = 0; i < 36; ++i) lg[i] = wave_sum(lg[i]);
    if (lane == 0) {
        float best = lg[0] + brg[0]; int gi = 0;
#pragma unroll
        for (int i = 1; i < 4; ++i) { const float t = lg[i] + brg[i]; if (t > best) { best = t; gi = i; } }
        float den = 0;
#pragma unroll
        for (int i = 0; i < 4; ++i) den += expf(lg[i] + brg[i] - best);
        const float pg = 1.0f / den;
        float le[8];
#pragma unroll
        for (int i = 0; i < 8; ++i) { float t = 0.f;
#pragma unroll
            for (int g = 0; g < 4; ++g) { const float cand = lg[4 + g * 8 + i] + bre[g * 8 + i]; t = (gi == g) ? cand : t; }
            le[i] = t; }
        float v1 = le[0]; int i1 = 0;
#pragma unroll
        for (int i = 1; i < 8; ++i) if (le[i] > v1) { v1 = le[i]; i1 = i; }
        float v2 = -3.0e38f; int i2 = 0;
#pragma unroll
        for (int i = 0; i < 8; ++i) if (i != i1 && le[i] > v2) { v2 = le[i]; i2 = i; }
        const float w1 = 1.0f / (1.0f + expf(v2 - v1)), w2 = 1.0f - w1;
        const int e1 = gi * 8 + i1, e2 = gi * 8 + i2;
        TOKE[row * 2] = e1; TOKE[row * 2 + 1] = e2; TOKW[row * 2] = pg * w1; TOKW[row * 2 + 1] = pg * w2;
        const unsigned p1 = atomicAdd(cnt + e1, 1u); LIST[e1 * NT + p1] = row * 2;
        const unsigned p2 = atomicAdd(cnt + e2, 1u); LIST[e2 * NT + p2] = row * 2 + 1;
    }
}
__device__ __forceinline__ int expert_base(const unsigned* cnt, int e) { int b = 0; for (int i = 0; i < e; ++i) b += ((int)cnt[i] + 255) / 256 * 256; return b; }
__global__ void __launch_bounds__(256) n_moe_gu(const bf16* H2, const float* wg, const float* wu, const unsigned* cnt, const int* LIST, float* G, bf16* HID, int pass) {
    const int e = blockIdx.z, M = (int)cnt[e], m0 = blockIdx.y * 64; if (m0 >= M) return;
    const int base = expert_base(cnt, e);
    AL_bf16_gather al{H2, D, 0, LIST + (size_t)e * NT};
    if (pass == 0) { BL_plain bl{wg + (size_t)e * D * FF, FF, 0}; float* Gp = G + (size_t)base * FF;
        auto ep = [=](int row, int col, float v) { Gp[(size_t)row * FF + col] = v; }; ngemm_tile(m0, blockIdx.x * 64, M, D, al, bl, ep); }
    else { BL_plain bl{wu + (size_t)e * D * FF, FF, 0}; const float* Gp = G + (size_t)base * FF; bf16* Hp = HID + (size_t)base * FF;
        auto ep = [=](int row, int col, float v) { const float g = Gp[(size_t)row * FF + col]; Hp[(size_t)row * FF + col] = f2bf(g / (1.0f + expf(-g)) * v); }; ngemm_tile(m0, blockIdx.x * 64, M, D, al, bl, ep); }
}
__global__ void __launch_bounds__(256) n_moe_dn(const bf16* HID, const float* wd, const unsigned* cnt, const int* LIST, const float* TOKW, bf16* Y2) {
    const int e = blockIdx.z, M = (int)cnt[e], m0 = blockIdx.y * 64; if (m0 >= M) return;
    const int base = expert_base(cnt, e);
    AL_bf16 al{HID + (size_t)base * FF, FF, 0}; BL_plain bl{wd + (size_t)e * FF * D, D, 0}; const int* lst = LIST + (size_t)e * NT;
    auto ep = [=](int row, int col, float v) { const int t2 = lst[row]; Y2[(size_t)t2 * D + col] = f2bf(TOKW[t2] * v); };
    ngemm_tile(m0, blockIdx.x * 64, M, FF, al, bl, ep);
}
__global__ void __launch_bounds__(256) n_final(float* X1, const bf16* Y2, const float* mod, const float* g2l, const float* b2l) {
    const int row = blockIdx.x * 4 + (threadIdx.x >> 6), lane = threadIdx.x & 63, b = row / SEQ;
    float4* xr = (float4*)(X1 + (size_t)row * D); const float4* gt = (const float4*)(mod + (size_t)b * NMOD + 5 * D);
    float4 v[8]; float s = 0;
#pragma unroll
    for (int j = 0; j < 8; ++j) { const float4 x = xr[j * 64 + lane], g = gt[j * 64 + lane];
        const ushort4 ya = *(const ushort4*)(Y2 + (size_t)(row * 2) * D + (j * 64 + lane) * 4), yb = *(const ushort4*)(Y2 + (size_t)(row * 2 + 1) * D + (j * 64 + lane) * 4);
        v[j].x = ALPHA * x.x + g.x * (bf2f(ya.x) + bf2f(yb.x)); v[j].y = ALPHA * x.y + g.y * (bf2f(ya.y) + bf2f(yb.y)); v[j].z = ALPHA * x.z + g.z * (bf2f(ya.z) + bf2f(yb.z)); v[j].w = ALPHA * x.w + g.w * (bf2f(ya.w) + bf2f(yb.w));
        s += v[j].x + v[j].y + v[j].z + v[j].w; }
    const float mean = wave_sum(s) * (1.0f / D); float q = 0;
#pragma unroll
    for (int j = 0; j < 8; ++j) { v[j].x -= mean; v[j].y -= mean; v[j].z -= mean; v[j].w -= mean; q += v[j].x * v[j].x + v[j].y * v[j].y + v[j].z * v[j].z + v[j].w * v[j].w; }
    const float rstd = rsqrtf(wave_sum(q) * (1.0f / D) + EPS);
#pragma unroll
    for (int j = 0; j < 8; ++j) { const float4 g = ((const float4*)g2l)[j * 64 + lane], bb = ((const float4*)b2l)[j * 64 + lane];
        float4 o; o.x = v[j].x * rstd * g.x + bb.x; o.y = v[j].y * rstd * g.y + bb.y; o.z = v[j].z * rstd * g.z + bb.z; o.w = v[j].w * rstd * g.w + bb.w; xr[j * 64 + lane] = o; }
}


#define LAS __attribute__((address_space(3)))
#define GAS __attribute__((address_space(1)))
#define XB_TMO      128
#define XB_XCNT(j)  (256  + 64 * (j))
#define XB_XSUB(j)  (1280 + 64 * (j))
#define XB_XGEN(j)  (2304 + 64 * (j))
#define XB_TOP      3328
#define XB_TOPGEN   3392
#define XCD_BAR_WORDS 3456
#define XB_SPIN_CAP (1u << 18)

__device__ __forceinline__ unsigned xb_ld(unsigned* p)              { return __hip_atomic_load(p, __ATOMIC_RELAXED, __HIP_MEMORY_SCOPE_AGENT); }
__device__ __forceinline__ unsigned xb_add(unsigned* p, unsigned v) { return __hip_atomic_fetch_add(p, v, __ATOMIC_RELAXED, __HIP_MEMORY_SCOPE_AGENT); }
__device__ __forceinline__ unsigned xb_xcc_id() { return (unsigned)__builtin_amdgcn_s_getreg((3 << 11) | 20) & 0xFu; }
#define XB_SPIN(cond, bar) do { unsigned _sp = 0; while (cond) { __builtin_amdgcn_s_sleep(1); \
    if ((++_sp & 255u) == 0u) { if (xb_ld(&(bar)[XB_TMO])) break; if (_sp > XB_SPIN_CAP) { atomicAdd(&(bar)[XB_TMO], 1u); break; } } } } while (0)

struct XcdBarrier {
    unsigned* bar; unsigned x;
    volatile LAS unsigned* st;
};

__device__ __forceinline__ XcdBarrier xcd_barrier_post(unsigned* bar, volatile LAS unsigned* st) {
    XcdBarrier b; b.bar = bar; b.x = xb_xcc_id(); b.st = st;
    if (threadIdx.x == 0) (void)xb_add(&bar[XB_XCNT(b.x)], 1u);
    return b;
}
__device__ __forceinline__ void xcd_barrier_complete(unsigned* bar, unsigned x, unsigned& nloc, unsigned& nx) {
    const unsigned G = gridDim.x * gridDim.y * gridDim.z;
    unsigned sum, cnt, mine, sp = 0u;
    for (;;) {
        sum = 0u; cnt = 0u; mine = 0u;
#pragma unroll
        for (unsigned j = 0; j < 16; ++j) { const unsigned c = xb_ld(&bar[XB_XCNT(j)]); sum += c; cnt += (c > 0u) ? 1u : 0u; mine = (j == x) ? c : mine; }
        if (sum == G) break;
        __builtin_amdgcn_s_sleep(1);
        if ((++sp & 255u) == 0u) { if (xb_ld(&bar[XB_TMO])) break; if (sp > XB_SPIN_CAP) { atomicAdd(&bar[XB_TMO], 1u); break; } }
    }
    nloc = mine > 0u ? mine : 1u; nx = cnt > 0u ? cnt : 1u;
}

__device__ __forceinline__ void xcd_barrier(const XcdBarrier& b) {
    asm volatile("s_waitcnt vmcnt(0)" ::: "memory");
    __syncthreads();
    if (threadIdx.x == 0) {
        unsigned* bar = b.bar;
        __builtin_amdgcn_s_waitcnt(0);
        unsigned nloc = b.st[0], nx = b.st[1];
        if (nloc == 0u) { xcd_barrier_complete(bar, b.x, nloc, nx); b.st[0] = nloc; b.st[1] = nx; }
        const unsigned old = xb_add(&bar[XB_XSUB(b.x)], 1u);
        const unsigned gen = old / nloc;
        if (old + 1u == (gen + 1u) * nloc) {
            __builtin_amdgcn_fence(__ATOMIC_RELEASE, "agent");
            asm volatile("s_waitcnt vmcnt(0)" ::: "memory");
            const unsigned og = xb_add(&bar[XB_TOP], 1u);
            const unsigned tg = og / nx;
            if (og + 1u == (tg + 1u) * nx) xb_add(&bar[XB_TOPGEN], 1u);
            else XB_SPIN(xb_ld(&bar[XB_TOPGEN]) == tg, bar);
            __builtin_amdgcn_fence(__ATOMIC_ACQUIRE, "agent");
            xb_add(&bar[XB_XGEN(b.x)], 1u);
            asm volatile("s_waitcnt vmcnt(0)" ::: "memory");
        } else {
            XB_SPIN(xb_ld(&bar[XB_XGEN(b.x)]) == gen, bar);
            __builtin_amdgcn_fence(__ATOMIC_ACQUIRE, "agent");
            asm volatile("s_waitcnt vmcnt(0)" ::: "memory");
        }
    }
    __syncthreads();
}

typedef short bf16x8 __attribute__((ext_vector_type(8)));
typedef float f32x4 __attribute__((ext_vector_type(4)));
typedef float f32x2 __attribute__((ext_vector_type(2)));
typedef unsigned u32x4 __attribute__((ext_vector_type(4)));
typedef unsigned u32x2 __attribute__((ext_vector_type(2)));
#define LDS_WAIT() asm volatile("s_waitcnt lgkmcnt(0)" ::: "memory")
#define VM_WAIT() asm volatile("s_waitcnt vmcnt(0)" ::: "memory")
__device__ __forceinline__ unsigned cvt_pk_bf16(float lo, float hi) { unsigned r; asm volatile("v_cvt_pk_bf16_f32 %0, %1, %2" : "=v"(r) : "v"(lo), "v"(hi)); return r; }
__device__ __forceinline__ u32x4 pack8(const f32x4 a, const f32x4 b) { u32x4 w; w.x = cvt_pk_bf16(a[0], a[1]); w.y = cvt_pk_bf16(a[2], a[3]); w.z = cvt_pk_bf16(b[0], b[1]); w.w = cvt_pk_bf16(b[2], b[3]); return w; }
__device__ __forceinline__ u32x2 pack4(const f32x4 a) { u32x2 w; w.x = cvt_pk_bf16(a[0], a[1]); w.y = cvt_pk_bf16(a[2], a[3]); return w; }
__device__ __forceinline__ float gelu_fast(float x) {
    const float a = -2.3022081985f * x * (1.0f + 0.044715f * x * x); return x * __builtin_amdgcn_rcpf(1.0f + __builtin_amdgcn_exp2f(a)); }
__device__ __forceinline__ f32x4 gelu4(const f32x4 v) { f32x4 o; o[0] = gelu_fast(v[0]); o[1] = gelu_fast(v[1]); o[2] = gelu_fast(v[2]); o[3] = gelu_fast(v[3]); return o; }
__host__ __device__ __forceinline__ int rope_perm(int t) { const int n2 = t >> 5, i = t & 31; return 32 * (i >> 4) + 8 * ((i & 15) >> 2) + 4 * n2 + (i & 3); }

namespace pg8 {
constexpr int BM = 256, BK = 64, HALF = 128, HTB = HALF * BK * 2, STAGE_BYTES = 8 * HTB, NXCD = 8, WGM = 8;
__host__ __device__ __forceinline__ int lds_byte(int r, int c) { const int st = (r >> 4) * 2 + (c >> 5), rr = r & 15, cc = c & 31, ob = rr * 64 + cc * 2; return st * 1024 + (ob ^ (((ob >> 9) & 1) << 5)); }
__host__ __device__ __forceinline__ void stage_rc(int b, int& R, int& C) { const int st = b / 1024, sb = b % 1024, swz = sb ^ (((sb >> 9) & 1) << 5); R = (st >> 1) * 16 + swz / 64; C = (st & 1) * 32 + (swz % 64) / 2; }
__host__ __device__ __forceinline__ int perm32(int rho) { const int n = rho >> 4, i = rho & 15; return 8 * (i >> 2) + 4 * n + (i & 3); }

struct Unit { const char* a; const char* b; int i0, i1, i2, i3, i4, i5; };

struct DenseOrder {
    const char* A; const char* Bt; int nM, nN, nwg, G, c; size_t astep, bstep;
    __device__ __forceinline__ void init(const void* A_, int lda, const void* Bt_, int K, int M, int N, int G_, int c_) { A = (const char*)A_; Bt = (const char*)Bt_; nM = M / BM; nN = N / BM; nwg = nM * nN; G = G_; c = c_; astep = (size_t)BM * lda * 2; bstep = (size_t)BM * K * 2; }
    __device__ __forceinline__ bool next(int i, Unit& u) const {
        const long L = (long)i * G + c; if (L >= nwg) return false;
        int wgid = (int)L; { const int q = nwg / NXCD, r = nwg % NXCD, xcd = wgid % NXCD, off = wgid / NXCD; wgid = (xcd < r ? xcd * (q + 1) : r * (q + 1) + (xcd - r) * q) + off; }
        const int nig = WGM * nN, gid = wgid / nig, fm = gid * WGM, gsz = (nM - fm) < WGM ? (nM - fm) : WGM;
        u.i0 = fm + ((wgid % nig) % gsz); u.i1 = (wgid % nig) / gsz; u.i2 = 0; u.i3 = 0; u.i4 = 0; u.i5 = 0;
        u.a = A + (size_t)u.i0 * astep; u.b = Bt + (size_t)u.i1 * bstep; return true;
    }
    __device__ __forceinline__ unsigned rowoff(const Unit&, int) const { return 0u; }
};

template <class Epi, class Sched, bool GATHER, bool ALIGN_EPI>
__device__ __forceinline__ void gemm_phase(LAS unsigned char* lds, const int K, const int lda, const Sched& S, const Epi& E) {
    const int tid = threadIdx.x, wid = __builtin_amdgcn_readfirstlane(tid >> 6), lane = tid & 63, wr = wid >> 2, wc = wid & 3, fr = lane & 15, fq = lane >> 4;
    const int nt = K / BK;
    unsigned voffA[2], voffB[2]; int Rr[2]; unsigned Cc[2];
#pragma unroll
    for (int i = 0; i < 2; ++i) { int R, C; stage_rc(tid * 16 + i * 8192, R, C); const int Rb = Epi::PERM ? ((R & ~31) + perm32(R & 31)) : R;
        voffA[i] = (unsigned)(R * lda + C) * 2u; voffB[i] = (unsigned)(Rb * K + C) * 2u; Rr[i] = R; Cc[i] = (unsigned)C * 2u; }
    const size_t kstep = (size_t)(BK * 2);
    const size_t hstepA = (size_t)HALF * lda * 2, hstepB = (size_t)HALF * K * 2;
    const unsigned ldsw = (unsigned)wid * 1024u;
    const int aoff = lds_byte(wr * 64 + fr, fq * 8), boff = lds_byte(wc * 32 + fr, fq * 8);
#define PG8_SA(b, h) (((b) * 2 + (h)) * HTB)
#define PG8_SB(b, h) ((4 + (b) * 2 + (h)) * HTB)
#define PG8_GL(gp, lp) __builtin_amdgcn_global_load_lds((const unsigned*)(gp), (LAS unsigned*)(lp), 16, 0, 0)
#define PG8_STAGE_B(bufoff, gbase) do { PG8_GL((const char*)(gbase) + voffB[0], lds + (bufoff) + ldsw); PG8_GL((const char*)(gbase) + voffB[1], lds + (bufoff) + ldsw + 8192); } while (0)
#define PG8_STAGE_A(bufoff, gbase, h, NX) do { if constexpr (GATHER) { const unsigned _o0 = (NX) ? gN[h][0] : gA[h][0], _o1 = (NX) ? gN[h][1] : gA[h][1]; \
            PG8_GL((const char*)(gbase) + _o0, lds + (bufoff) + ldsw); PG8_GL((const char*)(gbase) + _o1, lds + (bufoff) + ldsw + 8192); } \
        else { PG8_GL((const char*)(gbase) + (h) * hstepA + voffA[0], lds + (bufoff) + ldsw); PG8_GL((const char*)(gbase) + (h) * hstepA + voffA[1], lds + (bufoff) + ldsw + 8192); } } while (0)
#define PG8_LDA(dst, b, h) do { _Pragma("unroll") for (int m = 0; m < 4; ++m) _Pragma("unroll") for (int k = 0; k < 2; ++k) dst[m][k] = *(const LAS bf16x8*)(lds + PG8_SA(b, h) + aoff + m * 2048 + k * 1024); } while (0)
#define PG8_LDB(dst, b, h) do { _Pragma("unroll") for (int n = 0; n < 2; ++n) _Pragma("unroll") for (int k = 0; k < 2; ++k) dst[n][k] = *(const LAS bf16x8*)(lds + PG8_SB(b, h) + boff + n * 2048 + k * 1024); } while (0)
#define PG8_MMA(ai, bj, At, Bt) do { __builtin_amdgcn_s_setprio(1); _Pragma("unroll") for (int m = 0; m < 4; ++m) _Pragma("unroll") for (int n = 0; n < 2; ++n) _Pragma("unroll") for (int k = 0; k < 2; ++k) \
        acc[ai][bj][m][n] = __builtin_amdgcn_mfma_f32_16x16x32_bf16(Bt[n][k], At[m][k], acc[ai][bj][m][n], 0, 0, 0); __builtin_amdgcn_s_setprio(0); } while (0)
#define PG8_WAIT_V(n) asm volatile("s_waitcnt vmcnt(" #n ")" ::: "memory")
#define PG8_WAIT_L(n) asm volatile("s_waitcnt lgkmcnt(" #n ")" ::: "memory")
#define PG8_BAR __builtin_amdgcn_s_barrier()
#define PG8_SCHED __builtin_amdgcn_sched_barrier(0)
    Unit cur, nxt; int ui = 0;
    if (!S.next(0, cur)) return;
    unsigned gA[2][2], gN[2][2];
#pragma unroll
    for (int h = 0; h < 2; ++h)
#pragma unroll
        for (int i = 0; i < 2; ++i) { gA[h][i] = GATHER ? S.rowoff(cur, h * HALF + Rr[i]) + Cc[i] : 0u; gN[h][i] = gA[h][i]; }
    f32x4 acc[2][2][4][2];
#pragma unroll
    for (int a = 0; a < 2; ++a)
#pragma unroll
        for (int b = 0; b < 2; ++b)
#pragma unroll
            for (int m = 0; m < 4; ++m)
#pragma unroll
                for (int n = 0; n < 2; ++n) acc[a][b][m][n] = (f32x4){0.f, 0.f, 0.f, 0.f};
    bf16x8 At[4][2], B0[2][2], B1[2][2];
    const char* cA = cur.a; const char* cB = cur.b;
    PG8_STAGE_B(PG8_SB(0, 0), cB); PG8_STAGE_B(PG8_SB(0, 1), cB + hstepB); PG8_STAGE_A(PG8_SA(0, 0), cA, 0, false); PG8_STAGE_A(PG8_SA(0, 1), cA, 1, false);
    if (wr == 1) PG8_BAR;
    PG8_WAIT_V(2); PG8_BAR;
    PG8_STAGE_B(PG8_SB(1, 0), cB + kstep); PG8_STAGE_A(PG8_SA(1, 0), cA + kstep, 0, false); PG8_STAGE_B(PG8_SB(1, 1), cB + hstepB + kstep);
    PG8_WAIT_V(6); PG8_BAR;
    for (;;) {
        const bool has_next = S.next(ui + 1, nxt);
        const char* nA = has_next ? nxt.a : cA; const char* nB = has_next ? nxt.b : cB;
        if constexpr (GATHER) { if (has_next) {
#pragma unroll
            for (int h = 0; h < 2; ++h)
#pragma unroll
                for (int i = 0; i < 2; ++i) gN[h][i] = S.rowoff(nxt, h * HALF + Rr[i]) + Cc[i]; } }
        for (int t = 0; t < nt; t += 2) {
            const bool last = (t == nt - 2);
            const char* a1 = cA + (size_t)(t + 1) * kstep;
            const char* a2 = last ? nA : cA + (size_t)(t + 2) * kstep; const char* b2 = last ? nB : cB + (size_t)(t + 2) * kstep;
            const char* a3 = a2 + kstep; const char* b3 = b2 + kstep;
            PG8_LDB(B0, 0, 0); PG8_LDB(B1, 0, 1); PG8_SCHED; PG8_LDA(At, 0, 0); PG8_STAGE_A(PG8_SA(1, 1), a1, 1, false);
            PG8_WAIT_V(8); PG8_WAIT_L(0); PG8_BAR; PG8_MMA(0, 0, At, B0); PG8_MMA(0, 1, At, B1); PG8_BAR; PG8_SCHED;
            PG8_LDA(At, 0, 1); PG8_STAGE_B(PG8_SB(0, 0), b2); PG8_STAGE_B(PG8_SB(0, 1), b2 + hstepB); PG8_STAGE_A(PG8_SA(0, 0), a2, 0, last);
            PG8_WAIT_V(8); PG8_WAIT_L(0); PG8_BAR; PG8_MMA(1, 0, At, B0); PG8_MMA(1, 1, At, B1); PG8_BAR; PG8_SCHED;
            PG8_LDB(B0, 1, 0); PG8_LDB(B1, 1, 1); PG8_SCHED; PG8_LDA(At, 1, 0); PG8_STAGE_A(PG8_SA(0, 1), a2, 1, last);
            PG8_WAIT_V(8); PG8_WAIT_L(0); PG8_BAR; PG8_MMA(0, 0, At, B0); PG8_MMA(0, 1, At, B1); PG8_BAR; PG8_SCHED;
            PG8_LDA(At, 1, 1); PG8_STAGE_B(PG8_SB(1, 0), b3); PG8_STAGE_B(PG8_SB(1, 1), b3 + hstepB); PG8_STAGE_A(PG8_SA(1, 0), a3, 0, last);
            PG8_WAIT_V(8); PG8_WAIT_L(0); PG8_BAR; PG8_MMA(1, 0, At, B0); PG8_MMA(1, 1, At, B1); PG8_BAR; PG8_SCHED;
        }
        if constexpr (ALIGN_EPI) { if (wr == 0) PG8_BAR; }
        E(acc, cur, wr, wc, fr, fq);
        if (!has_next) break;
#pragma unroll
        for (int a = 0; a < 2; ++a)
#pragma unroll
            for (int b = 0; b < 2; ++b)
#pragma unroll
                for (int m = 0; m < 4; ++m)
#pragma unroll
                    for (int n = 0; n < 2; ++n) acc[a][b][m][n] = (f32x4){0.f, 0.f, 0.f, 0.f};
        cur = nxt; cA = nA; cB = nB; ++ui;
        if constexpr (GATHER) {
#pragma unroll
            for (int h = 0; h < 2; ++h)
#pragma unroll
                for (int i = 0; i < 2; ++i) gA[h][i] = gN[h][i]; }
        if constexpr (ALIGN_EPI) { if (wr == 1) PG8_BAR; }
    }
    PG8_WAIT_V(0);
    if constexpr (!ALIGN_EPI) { if (wr == 0) PG8_BAR; }
    PG8_BAR;
#undef PG8_SA
#undef PG8_SB
#undef PG8_GL
#undef PG8_STAGE_A
#undef PG8_STAGE_B
#undef PG8_LDA
#undef PG8_LDB
#undef PG8_MMA
#undef PG8_WAIT_V
#undef PG8_WAIT_L
#undef PG8_BAR
#undef PG8_SCHED
}
}

constexpr int NWAVES = 8, NTHREADS = 512;
constexpr int RING_BYTES = 131072;
constexpr int MISC_OFF = RING_BYTES;
constexpr int TAB_OFF = RING_BYTES + 256;
constexpr int LDS_BYTES = 147456;
constexpr int CW_BAR = 4096;
constexpr int NPH = 10;

struct Args { const void* in[26]; float* out; unsigned char* ws; int ph_lo, ph_hi, li, pad; };

struct Frame {
    LAS unsigned char* lds; volatile LAS unsigned* MISC;
    int tid, lane, wave, vcu, G;
    unsigned char* ws; float* out;
};

using pg8::Unit;
struct EpiProj { static constexpr bool PERM = true;
    bf16* CQ; bf16* CKV; bf16* U; bf16* VS; bf16* Kb; float* SSQQ; float* SSQKV; float* VSST; const float2* RT;
    __device__ __forceinline__ void operator()(const f32x4 (&acc)[2][2][4][2], const Unit& u, int wr, int wc, int fr, int fq) const {
        const int pm = u.i0, pn = u.i1, row0 = pm * 256 + wr * 64 + fr;
        if (pn < 5) {
            const bool isq = pn < 3; bf16* dst = isq ? CQ : CKV; const int ld = isq ? QL : KVL, tn = isq ? pn : pn - 3, np = isq ? NPQ : NPKV; float* ss = isq ? SSQQ : SSQKV;
#pragma unroll
            for (int ai = 0; ai < 2; ++ai)
#pragma unroll
                for (int m = 0; m < 4; ++m) { const int row = row0 + ai * 128 + m * 16; float q = 0.f;
#pragma unroll
                    for (int bj = 0; bj < 2; ++bj) { const f32x4 v0 = acc[ai][bj][m][0], v1 = acc[ai][bj][m][1];
                        q += (v0[0] * v0[0] + v0[1] * v0[1]) + (v0[2] * v0[2] + v0[3] * v0[3]) + (v1[0] * v1[0] + v1[1] * v1[1]) + (v1[2] * v1[2] + v1[3] * v1[3]);
                        *(u32x4*)(dst + (size_t)row * ld + tn * 256 + bj * 128 + wc * 32 + 8 * fq) = pack8(v0, v1); }
                    q += __shfl_xor(q, 16); q += __shfl_xor(q, 32);
                    if (fq == 0) ss[(size_t)row * np + tn * 4 + wc] = q; }
        } else if (pn == 5) {
            if (wc < 2) {
#pragma unroll
                for (int ai = 0; ai < 2; ++ai)
#pragma unroll
                    for (int m = 0; m < 4; ++m) { const int row = row0 + ai * 128 + m * 16, b = row / SEQ, s = row % SEQ, i0 = 16 * wc + 4 * fq;
                        const f32x4 x1 = acc[ai][0][m][0], x2 = acc[ai][0][m][1]; const f32x4* cs = (const f32x4*)(RT + (size_t)row * 32 + i0); const f32x4 c01 = cs[0], c23 = cs[1];
                        f32x4 o1, o2;
                        o1[0] = x1[0] * c01[0] - x2[0] * c01[1]; o2[0] = x2[0] * c01[0] + x1[0] * c01[1]; o1[1] = x1[1] * c01[2] - x2[1] * c01[3]; o2[1] = x2[1] * c01[2] + x1[1] * c01[3];
                        o1[2] = x1[2] * c23[0] - x2[2] * c23[1]; o2[2] = x2[2] * c23[0] + x1[2] * c23[1]; o1[3] = x1[3] * c23[2] - x2[3] * c23[3]; o2[3] = x2[3] * c23[2] + x1[3] * c23[3];
                        const u32x2 p1 = pack4(o1), p2 = pack4(o2);
#pragma unroll
                        for (int h = 0; h < NH; ++h) { bf16* kr = Kb + ((size_t)(b * NH + h) * SEQ + s) * QKD + NOPE; *(u32x2*)(kr + i0) = p1; *(u32x2*)(kr + 32 + i0) = p2; } }
            }
        } else {
            const int zt = pn - 6; const bool isu = zt < 4; bf16* dst = isu ? U + zt * 256 : VS + (zt - 4) * 256;
#pragma unroll
            for (int ai = 0; ai < 2; ++ai)
#pragma unroll
                for (int m = 0; m < 4; ++m) { const int row = row0 + ai * 128 + m * 16; float s1 = 0.f, s2 = 0.f;
#pragma unroll
                    for (int bj = 0; bj < 2; ++bj) { const f32x4 v0 = gelu4(acc[ai][bj][m][0]), v1 = gelu4(acc[ai][bj][m][1]);
                        s1 += (v0[0] + v0[1]) + (v0[2] + v0[3]) + (v1[0] + v1[1]) + (v1[2] + v1[3]);
                        s2 += (v0[0] * v0[0] + v0[1] * v0[1]) + (v0[2] * v0[2] + v0[3] * v0[3]) + (v1[0] * v1[0] + v1[1] * v1[1]) + (v1[2] * v1[2] + v1[3] * v1[3]);
                        *(u32x4*)(dst + (size_t)row * SGW + bj * 128 + wc * 32 + 8 * fq) = pack8(v0, v1); }
                    if (!isu) { s1 += __shfl_xor(s1, 16); s1 += __shfl_xor(s1, 32); s2 += __shfl_xor(s2, 16); s2 += __shfl_xor(s2, 32);
                        if (fq == 0) { f32x2 st; st.x = s1; st.y = s2; *(f32x2*)(VSST + (size_t)row * 2 * NPVS + ((zt - 4) * 4 + wc) * 2) = st; } } }
        }
    }
};
struct EpiQ { static constexpr bool PERM = true;
    const float* SSQQ; const float2* RT; bf16* Q;
    __device__ __forceinline__ void operator()(const f32x4 (&acc)[2][2][4][2], const Unit& u, int wr, int wc, int fr, int fq) const {
        const int pm = u.i0, pn = u.i1, row0 = pm * 256 + wr * 64 + fr;
#pragma unroll
        for (int ai = 0; ai < 2; ++ai)
#pragma unroll
            for (int m = 0; m < 4; ++m) { const int row = row0 + ai * 128 + m * 16, b = row / SEQ, s = row % SEQ;
                const f32x4* sp = (const f32x4*)(SSQQ + (size_t)row * NPQ); const f32x4 p0 = sp[0], p1 = sp[1], p2 = sp[2];
                const float tot = ((p0[0] + p0[1]) + (p0[2] + p0[3])) + ((p1[0] + p1[1]) + (p1[2] + p1[3])) + ((p2[0] + p2[1]) + (p2[2] + p2[3]));
                const float rs = rsqrtf(tot * (1.0f / QL) + EPS) * QSCALE;
#pragma unroll
                for (int bj = 0; bj < 2; ++bj) { const int gcol0 = 256 * pn + 128 * bj + 32 * wc, h = gcol0 / QKD, dg = (gcol0 % QKD) / 32;
                    bf16* qrow = Q + ((size_t)(b * NH + h) * SEQ + s) * QKD; const f32x4 v0 = acc[ai][bj][m][0] * rs, v1 = acc[ai][bj][m][1] * rs;
                    if (dg < 4) *(u32x4*)(qrow + 32 * dg + 8 * fq) = pack8(v0, v1);
                    else { const int i0 = 16 * (dg - 4) + 4 * fq; const f32x4* cs = (const f32x4*)(RT + (size_t)row * 32 + i0); const f32x4 c01 = cs[0], c23 = cs[1];
                        f32x4 o1, o2;
                        o1[0] = v0[0] * c01[0] - v1[0] * c01[1]; o2[0] = v1[0] * c01[0] + v0[0] * c01[1]; o1[1] = v0[1] * c01[2] - v1[1] * c01[3]; o2[1] = v1[1] * c01[2] + v0[1] * c01[3];
                        o1[2] = v0[2] * c23[0] - v1[2] * c23[1]; o2[2] = v1[2] * c23[0] + v0[2] * c23[1]; o1[3] = v0[3] * c23[2] - v1[3] * c23[3]; o2[3] = v1[3] * c23[2] + v0[3] * c23[3];
                        *(u32x2*)(qrow + NOPE + i0) = pack4(o1); *(u32x2*)(qrow + NOPE + 32 + i0) = pack4(o2); } } }
    }
};
struct EpiKV { static constexpr bool PERM = true;
    const float* SSQKV; bf16* Kb; bf16* Vb;
    __device__ __forceinline__ void operator()(const f32x4 (&acc)[2][2][4][2], const Unit& u, int wr, int wc, int fr, int fq) const {
        const int pm = u.i0, h = u.i1, row0 = pm * 256 + wr * 64 + fr;
#pragma unroll
        for (int ai = 0; ai < 2; ++ai)
#pragma unroll
            for (int m = 0; m < 4; ++m) { const int row = row0 + ai * 128 + m * 16, b = row / SEQ, s = row % SEQ;
                const f32x4* sp = (const f32x4*)(SSQKV + (size_t)row * NPKV); const f32x4 p0 = sp[0], p1 = sp[1];
                const float tot = ((p0[0] + p0[1]) + (p0[2] + p0[3])) + ((p1[0] + p1[1]) + (p1[2] + p1[3]));
                const float rs = rsqrtf(tot * (1.0f / KVL) + EPS);
                const size_t tr = (size_t)(b * NH + h) * SEQ + s;
                *(u32x4*)(Kb + tr * QKD + 32 * wc + 8 * fq) = pack8(acc[ai][0][m][0] * rs, acc[ai][0][m][1] * rs);
                *(u32x4*)(Vb + tr * VD + 32 * wc + 8 * fq) = pack8(acc[ai][1][m][0] * rs, acc[ai][1][m][1] * rs); }
    }
};
struct EpiWo { static constexpr bool PERM = false;
    const float* x; const float* mod; float* V1;
    __device__ __forceinline__ void operator()(const f32x4 (&acc)[2][2][4][2], const Unit& u, int wr, int wc, int fr, int fq) const {
        const int pm = u.i0, pn = u.i1, row0 = pm * 256 + wr * 64 + fr, col0 = pn * 256 + wc * 32 + 4 * fq, b = (pm * 256) / SEQ;
        f32x4 gv[2][2];
#pragma unroll
        for (int bj = 0; bj < 2; ++bj)
#pragma unroll
            for (int n = 0; n < 2; ++n) gv[bj][n] = *(const f32x4*)(mod + (size_t)b * NMOD + 2 * D + col0 + bj * 128 + n * 16);
#pragma unroll
        for (int ai = 0; ai < 2; ++ai)
#pragma unroll
            for (int m = 0; m < 4; ++m) { const size_t off = (size_t)(row0 + ai * 128 + m * 16) * D + col0;
#pragma unroll
                for (int bj = 0; bj < 2; ++bj)
#pragma unroll
                    for (int n = 0; n < 2; ++n) { const f32x4 xv = *(const f32x4*)(x + off + bj * 128 + n * 16); *(f32x4*)(V1 + off + bj * 128 + n * 16) = xv * ALPHA + gv[bj][n] * acc[ai][bj][m][n]; }
                asm volatile("" ::: "memory"); }
    }
};
struct EpiGU { static constexpr bool PERM = true;
    bf16* HID;
    __device__ __forceinline__ void operator()(const f32x4 (&acc)[2][2][4][2], const Unit& u, int wr, int wc, int fr, int fq) const {
        const int t = u.i1, pn = u.i2, valid = u.i3;
#pragma unroll
        for (int ai = 0; ai < 2; ++ai)
#pragma unroll
            for (int m = 0; m < 4; ++m) { const int r = ai * 128 + wr * 64 + m * 16 + fr;
                if (r < valid) { f32x4 h0, h1;
#pragma unroll
                    for (int j = 0; j < 4; ++j) { const float g0 = acc[ai][0][m][0][j], g1 = acc[ai][0][m][1][j];
                        h0[j] = g0 * __builtin_amdgcn_rcpf(1.0f + __builtin_amdgcn_exp2f(-1.4426950409f * g0)) * acc[ai][1][m][0][j];
                        h1[j] = g1 * __builtin_amdgcn_rcpf(1.0f + __builtin_amdgcn_exp2f(-1.4426950409f * g1)) * acc[ai][1][m][1][j]; }
                    *(u32x4*)(HID + (size_t)(256 * t + r) * FF + 128 * pn + 32 * wc + 8 * fq) = pack8(h0, h1); } }
    }
};
struct EpiDown { static constexpr bool PERM = true;
    const int* LIST; const float* TOKW; bf16* Y2;
    __device__ __forceinline__ void operator()(const f32x4 (&acc)[2][2][4][2], const Unit& u, int wr, int wc, int fr, int fq) const {
        const int e = u.i0, pn = u.i2, valid = u.i3, l0 = u.i4;
#pragma unroll
        for (int ai = 0; ai < 2; ++ai)
#pragma unroll
            for (int m = 0; m < 4; ++m) { const int r = ai * 128 + wr * 64 + m * 16 + fr;
                if (r < valid) { const int t2 = LIST[(size_t)e * NT + l0 + r]; const float w = TOKW[t2]; bf16* yr = Y2 + (size_t)t2 * D + 256 * pn + 32 * wc + 8 * fq;
                    *(u32x4*)(yr) = pack8(acc[ai][0][m][0] * w, acc[ai][0][m][1] * w); *(u32x4*)(yr + 128) = pack8(acc[ai][1][m][0] * w, acc[ai][1][m][1] * w); } }
    }
};
struct MoeOrder {
    const LAS int* tab;
    const char* A; const char* Bt; const int* LIST; int ntn, G, c; size_t bstep_e, bstep_n, astep;
    __device__ __forceinline__ bool next(int i, Unit& u) const {
        const int ntile = tab[128]; const long L = (long)i * G + c; if (L >= (long)ntile * ntn) return false;
        const int t = (int)(L / ntn), pn = (int)(L % ntn), e = tab[t], mt = t - tab[192 + e], cnt = tab[160 + e];
        u.i0 = e; u.i1 = t; u.i2 = pn; u.i3 = (cnt - 256 * mt) < 256 ? (cnt - 256 * mt) : 256; u.i4 = 256 * mt; u.i5 = cnt;
        u.a = A + (size_t)t * astep; u.b = Bt + (size_t)e * bstep_e + (size_t)pn * bstep_n; return true;
    }
    __device__ __forceinline__ unsigned rowoff(const Unit& u, int r) const {
        int idx = u.i4 + r; idx = idx < u.i5 ? idx : u.i5 - 1; const int tok = LIST[(size_t)u.i0 * NT + idx] >> 1; return (unsigned)tok * (unsigned)(D * 2); }
};
__device__ __forceinline__ void moe_build_table(Frame& F, const unsigned* cnt) {
    LAS int* tab = (LAS int*)(F.lds + TAB_OFF);
    if (F.tid == 0) { int t = 0; for (int e = 0; e < NE; ++e) { const int c = (int)cnt[e]; tab[160 + e] = c; tab[192 + e] = t; const int n = (c + 255) / 256; for (int j = 0; j < n && t < 128; ++j) tab[t++] = e; } tab[128] = t; }
    LDS_WAIT(); __syncthreads();
}

template <class DR>
__device__ __forceinline__ void tr_item(const float* W, int N, int K, const float* ks, bf16* WT, LAS float* scr, int k0, int n0, int lane, const DR& dr) {
#pragma unroll 8
    for (int i = 0; i < 32; ++i) { const int kk = 2 * i + (lane >> 5); float v = W[(size_t)(k0 + kk) * N + n0 + (lane & 31)]; if (ks) v *= ks[k0 + kk]; scr[kk * 33 + (lane & 31)] = v; }
    LDS_WAIT(); asm volatile("" ::: "memory");
    const int c = lane & 7;
#pragma unroll
    for (int j = 0; j < 4; ++j) { const int n = (lane >> 3) + 8 * j; const LAS float* s = scr + (8 * c) * 33 + n;
        u32x4 o; o.x = cvt_pk_bf16(s[0 * 33], s[1 * 33]); o.y = cvt_pk_bf16(s[2 * 33], s[3 * 33]); o.z = cvt_pk_bf16(s[4 * 33], s[5 * 33]); o.w = cvt_pk_bf16(s[6 * 33], s[7 * 33]);
        *(GAS u32x4*)(WT + (size_t)dr(n0 + n) * K + k0 + 8 * c) = o; }
    LDS_WAIT(); asm volatile("" ::: "memory");
}
struct Ptrs {
    const float *x, *c, *w_ada, *b_ada, *w_in, *q_norm_g, *w_uq, *kv_norm_g, *w_ukv, *sgu_g, *sgu_b, *w_sp, *b_sp, *w_o, *ln1_g, *ln1_b, *wrg, *brg, *wre, *bre, *w_gate, *w_up, *w_down, *ln2_g, *ln2_b;
    const int* positions;
    float *MOD, *SSQQ, *SSQKV, *VSST, *TOKW; float2* RT; int *TOKE, *LIST; unsigned* cnt;
    bf16 *WIN, *WUQ, *WUKV, *WO, *WGU, *WDN, *WSP, *WRT, *H, *CQ, *CKV, *U, *VS, *Qb, *Kb, *Vb, *A2, *HID, *Y2;
};
__device__ __forceinline__ void p0_prologue(Frame& F, const Ptrs& P) {
    {
        LAS float* cl = (LAS float*)F.lds;
        LAS float* part = (LAS float*)(F.lds + 32768);
        for (int i = F.tid; i < NB * D / 4; i += NTHREADS) ((LAS f32x4*)cl)[i] = ((const f32x4*)P.c)[i];
        LDS_WAIT(); __syncthreads();
        for (int cb = F.vcu; cb < NMOD / 48; cb += F.G) {
            const int j0 = cb * 48, kk = F.lane >> 4, c4 = F.lane & 15; const bool act = c4 < 12;
            f32x4 a0 = {0.f, 0.f, 0.f, 0.f}, a1 = a0, a2 = a0, a3 = a0;
            const float* wp = P.w_ada + (size_t)(F.wave * 256 + kk) * NMOD + j0 + 4 * (act ? c4 : 0);
#pragma unroll 8
            for (int it = 0; it < 64; ++it) { const int k = F.wave * 256 + 4 * it + kk; f32x4 wv = *(const f32x4*)(wp + (size_t)(4 * it) * NMOD);
                a0 += wv * cl[k]; a1 += wv * cl[D + k]; a2 += wv * cl[2 * D + k]; a3 += wv * cl[3 * D + k]; }
#pragma unroll
            for (int j = 0; j < 4; ++j) { a0[j] += __shfl_xor(a0[j], 16); a0[j] += __shfl_xor(a0[j], 32); a1[j] += __shfl_xor(a1[j], 16); a1[j] += __shfl_xor(a1[j], 32);
                a2[j] += __shfl_xor(a2[j], 16); a2[j] += __shfl_xor(a2[j], 32); a3[j] += __shfl_xor(a3[j], 16); a3[j] += __shfl_xor(a3[j], 32); }
            if (F.lane < 12) { LAS f32x4* pp = (LAS f32x4*)(part + F.wave * 192) + F.lane; pp[0] = a0; pp[12] = a1; pp[24] = a2; pp[36] = a3; }
            LDS_WAIT(); __syncthreads();
            if (F.tid < 192) { float s = 0.f;
#pragma unroll
                for (int w = 0; w < 8; ++w) s += part[w * 192 + F.tid];
                const int b = F.tid / 48, col = F.tid % 48; P.MOD[(size_t)b * NMOD + j0 + col] = s + P.b_ada[j0 + col]; }
            __syncthreads();
        }
    }
    {
        LAS float* scr = (LAS float*)(F.lds + F.wave * 16384);
        const int gw = F.vcu * NWAVES + F.wave, NGW = F.G * NWAVES;
        constexpr int I_IN = (D / 64) * (INP / 32), I_UQ = (QL / 64) * (NH * QKD / 32), I_UKV = (KVL / 64) * (NH * 256 / 32), I_O = (D / 64) * (D / 32);
        constexpr int I_G1 = (D / 64) * (FF / 32), I_G = NE * I_G1, I_D1 = (FF / 64) * (D / 32), I_D = NE * I_D1;
        constexpr int NITEMS = I_IN + I_UQ + I_UKV + I_O + 2 * I_G + I_D;
        for (int it = gw; it < NITEMS; it += NGW) {
            int r = it;
            if (r < I_IN) { const int nb = INP / 32; tr_item(P.w_in, INP, D, nullptr, P.WIN, scr, 64 * (r / nb), 32 * (r % nb), F.lane,
                    [](int n) { return n < QL + KVL ? n : (n < QL + KVL + ROPE ? QL + KVL + rope_perm(n - QL - KVL) : n + 192); }); continue; } r -= I_IN;
            if (r < I_UQ) { const int nb = NH * QKD / 32; tr_item(P.w_uq, NH * QKD, QL, P.q_norm_g, P.WUQ, scr, 64 * (r / nb), 32 * (r % nb), F.lane,
                    [](int n) { const int h = n / QKD, d = n % QKD; return d < NOPE ? n : h * QKD + NOPE + rope_perm(d - NOPE); }); continue; } r -= I_UQ;
            if (r < I_UKV) { const int nb = NH * 256 / 32; tr_item(P.w_ukv, NH * 256, KVL, P.kv_norm_g, P.WUKV, scr, 64 * (r / nb), 32 * (r % nb), F.lane, [](int n) { return n; }); continue; } r -= I_UKV;
            if (r < I_O) { const int nb = D / 32; tr_item(P.w_o, D, D, nullptr, P.WO, scr, 64 * (r / nb), 32 * (r % nb), F.lane, [](int n) { return n; }); continue; } r -= I_O;
            if (r < 2 * I_G) { const int up = r >= I_G; if (up) r -= I_G; const int e = r / I_G1, q = r % I_G1, nb = FF / 32;
                tr_item((up ? P.w_up : P.w_gate) + (size_t)e * D * FF, FF, D, nullptr, P.WGU + (size_t)e * 1024 * D, scr, 64 * (q / nb), 32 * (q % nb), F.lane,
                    [up](int n) { return (n >> 7) * 256 + up * 128 + (n & 127); }); continue; } r -= 2 * I_G;
            { const int e = r / I_D1, q = r % I_D1, nb = D / 32;
              tr_item(P.w_down + (size_t)e * FF * D, D, FF, nullptr, P.WDN + (size_t)e * D * FF, scr, 64 * (q / nb), 32 * (q % nb), F.lane, [](int n) { return n; }); }
        }
    }
    {
        const int gt = F.vcu * NTHREADS + F.tid, NGT = F.G * NTHREADS;
        for (int i = gt; i < 192 * D / 8; i += NGT) ((u32x4*)(P.WIN + (size_t)(QL + KVL + ROPE) * D))[i] = (u32x4){0u, 0u, 0u, 0u};
        for (int i = gt; i < 48 * D; i += NGT) { const int j = i / D, k = i % D; const float v = j < 4 ? P.wrg[k * 4 + j] : (j < 36 ? P.wre[k * 32 + j - 4] : 0.f); P.WRT[i] = f2bf(v); }
        for (int i = gt; i < NG * CH * CH; i += NGT) { const int s = i % CH, t = (i / CH) % CH; P.WSP[i] = f2bf(s <= t ? P.w_sp[i] : 0.f); }
        for (int i = gt; i < NT * 32; i += NGT) { const int tok = i >> 5, j = i & 31; const float inv = 1.0f / powf(10000.0f, (float)(2 * j) / 64.0f); const float ang = (float)P.positions[tok] * inv;
            P.RT[i] = make_float2((float)cos((double)ang), (float)sin((double)ang)); }
    }
}
__device__ __forceinline__ void p1_lnmod(Frame& F, const Ptrs& P) {
    const int gw = F.vcu * NWAVES + F.wave, NGW = F.G * NWAVES;
    for (int row = gw; row < NT; row += NGW) { const int b = row / SEQ;
        const f32x4* xr = (const f32x4*)(P.x + (size_t)row * D); f32x4 v[8]; float s = 0.f;
#pragma unroll
        for (int j = 0; j < 8; ++j) { v[j] = xr[j * 64 + F.lane]; s += (v[j][0] + v[j][1]) + (v[j][2] + v[j][3]); }
        const float mean = wave_sum(s) * (1.0f / D); float q = 0.f;
#pragma unroll
        for (int j = 0; j < 8; ++j) { v[j] = v[j] - mean; q += (v[j][0] * v[j][0] + v[j][1] * v[j][1]) + (v[j][2] * v[j][2] + v[j][3] * v[j][3]); }
        const float rstd = rsqrtf(wave_sum(q) * (1.0f / D) + EPS);
        const f32x4* sh = (const f32x4*)(P.MOD + (size_t)b * NMOD); const f32x4* sc = (const f32x4*)(P.MOD + (size_t)b * NMOD + D);
#pragma unroll
        for (int j = 0; j < 8; ++j) { const f32x4 o = v[j] * rstd * (sc[j * 64 + F.lane] + 1.0f) + sh[j * 64 + F.lane]; *(u32x2*)(P.H + (size_t)row * D + (j * 64 + F.lane) * 4) = pack4(o); }
    }
}
__device__ __forceinline__ void sgu_units(Frame& F, const Ptrs& P) {
    constexpr int VTS = 136;
    LAS bf16* VT = (LAS bf16*)F.lds; LAS float* mu = (LAS float*)(F.lds + 128 * VTS * 2); LAS float* rs = mu + 128;
    const int fr = F.lane & 15, fq = F.lane >> 4;
    for (int un = F.vcu; un < (NT / CH) * NG; un += F.G) {
        const int bc = un >> 3, g = un & 7, row0 = bc * CH;
        if (F.tid < CH) { const f32x4* st = (const f32x4*)(P.VSST + (size_t)(row0 + F.tid) * 2 * NPVS); float s1 = 0.f, s2 = 0.f;
#pragma unroll
            for (int i = 0; i < 8; ++i) { const f32x4 t = st[i]; s1 += t[0] + t[2]; s2 += t[1] + t[3]; }
            const float m = s1 * (1.0f / SGW), var = fmaxf(s2 * (1.0f / SGW) - m * m, 0.f); mu[F.tid] = m; rs[F.tid] = rsqrtf(var + EPS); }
        LDS_WAIT(); __syncthreads();
#pragma unroll
        for (int itn = 0; itn < 4; ++itn) { const int item = F.tid + NTHREADS * itn, s = item >> 4, dg = item & 15, col = g * GD + dg * 8;
            const u32x4 raw = *(const u32x4*)(P.VS + (size_t)(row0 + s) * SGW + col);
            const f32x4 ga0 = *(const f32x4*)(P.sgu_g + col), ga1 = *(const f32x4*)(P.sgu_g + col + 4), be0 = *(const f32x4*)(P.sgu_b + col), be1 = *(const f32x4*)(P.sgu_b + col + 4);
            const float m = mu[s], r = rs[s]; const unsigned ww[4] = {raw.x, raw.y, raw.z, raw.w};
#pragma unroll
            for (int e = 0; e < 4; ++e) { const float lo = __uint_as_float(ww[e] << 16), hi = __uint_as_float(ww[e] & 0xffff0000u);
                const float g0 = e < 2 ? ga0[2 * e] : ga1[2 * e - 4], g1 = e < 2 ? ga0[2 * e + 1] : ga1[2 * e - 3], b0 = e < 2 ? be0[2 * e] : be1[2 * e - 4], b1 = e < 2 ? be0[2 * e + 1] : be1[2 * e - 3];
                VT[(dg * 8 + 2 * e) * VTS + s] = f2bf((lo - m) * r * g0 + b0); VT[(dg * 8 + 2 * e + 1) * VTS + s] = f2bf((hi - m) * r * g1 + b1); } }
        LDS_WAIT(); __syncthreads();
        f32x4 acc[8];
#pragma unroll
        for (int n = 0; n < 8; ++n) acc[n] = (f32x4){0.f, 0.f, 0.f, 0.f};
        const int t = 16 * F.wave + fr;
        bf16x8 wf[4];
#pragma unroll
        for (int k = 0; k < 4; ++k) wf[k] = *(const bf16x8*)(P.WSP + ((size_t)g * CH + t) * CH + 32 * k + 8 * fq);
#pragma unroll
        for (int k = 0; k < 4; ++k)
#pragma unroll
            for (int n = 0; n < 8; ++n) { const bf16x8 vf = *(const LAS bf16x8*)(VT + (16 * n + fr) * VTS + 32 * k + 8 * fq); acc[n] = __builtin_amdgcn_mfma_f32_16x16x32_bf16(vf, wf[k], acc[n], 0, 0, 0); }
        const float bias = P.b_sp[g * CH + t];
#pragma unroll
        for (int n = 0; n < 8; ++n) { const int d0 = 16 * n + 4 * fq; const u32x2 uu = *(const u32x2*)(P.U + (size_t)(row0 + t) * SGW + g * GD + d0);
            f32x4 o; o[0] = __uint_as_float(uu.x << 16) * (acc[n][0] + bias); o[1] = __uint_as_float(uu.x & 0xffff0000u) * (acc[n][1] + bias);
            o[2] = __uint_as_float(uu.y << 16) * (acc[n][2] + bias); o[3] = __uint_as_float(uu.y & 0xffff0000u) * (acc[n][3] + bias);
            *(u32x2*)(P.A2 + (size_t)(row0 + t) * D + SGW + g * GD + d0) = pack4(o); }
        __syncthreads();
    }
}
__device__ __forceinline__ void p6_mid(Frame& F, const Ptrs& P) {
    constexpr int HS = 2056;
    LAS bf16* Hs = (LAS bf16*)F.lds;
    LAS float* PART = (LAS float*)(F.lds + 65792);
    LAS float* LOG = (LAS float*)(F.lds + 65792 + 24576);
    LAS int* lc = (LAS int*)(F.lds + 65792 + 24576 + 3072);
    LAS int* sel = lc + 64;
    const int fr = F.lane & 15, fq = F.lane >> 4;
    for (int rb = F.vcu; rb < NT / 16; rb += F.G) {
        const int rowb = rb * 16;
        if (F.tid < 32) lc[F.tid] = 0;
        for (int rr = 0; rr < 2; ++rr) { const int lr = F.wave * 2 + rr, row = rowb + lr, b = row / SEQ;
            f32x4* xr = (f32x4*)(F.out + (size_t)row * D); f32x4 v[8]; float s = 0.f;
#pragma unroll
            for (int j = 0; j < 8; ++j) { v[j] = xr[j * 64 + F.lane]; s += (v[j][0] + v[j][1]) + (v[j][2] + v[j][3]); }
            float mean = wave_sum(s) * (1.0f / D), q = 0.f;
#pragma unroll
            for (int j = 0; j < 8; ++j) { v[j] = v[j] - mean; q += (v[j][0] * v[j][0] + v[j][1] * v[j][1]) + (v[j][2] * v[j][2] + v[j][3] * v[j][3]); }
            float rstd = rsqrtf(wave_sum(q) * (1.0f / D) + EPS); s = 0.f;
#pragma unroll
            for (int j = 0; j < 8; ++j) { v[j] = v[j] * rstd * ((const f32x4*)P.ln1_g)[j * 64 + F.lane] + ((const f32x4*)P.ln1_b)[j * 64 + F.lane]; xr[j * 64 + F.lane] = v[j]; s += (v[j][0] + v[j][1]) + (v[j][2] + v[j][3]); }
            mean = wave_sum(s) * (1.0f / D); q = 0.f;
#pragma unroll
            for (int j = 0; j < 8; ++j) { v[j] = v[j] - mean; q += (v[j][0] * v[j][0] + v[j][1] * v[j][1]) + (v[j][2] * v[j][2] + v[j][3] * v[j][3]); }
            rstd = rsqrtf(wave_sum(q) * (1.0f / D) + EPS);
            const f32x4* sh = (const f32x4*)(P.MOD + (size_t)b * NMOD + 3 * D); const f32x4* sc = (const f32x4*)(P.MOD + (size_t)b * NMOD + 4 * D);
#pragma unroll
            for (int j = 0; j < 8; ++j) { const f32x4 o = v[j] * rstd * (sc[j * 64 + F.lane] + 1.0f) + sh[j * 64 + F.lane]; const u32x2 pk = pack4(o);
                *(u32x2*)(P.H + (size_t)row * D + (j * 64 + F.lane) * 4) = pk; *(LAS u32x2*)(Hs + lr * HS + (j * 64 + F.lane) * 4) = pk; }
        }
        LDS_WAIT(); __syncthreads();
        { f32x4 acc[3] = {{0.f, 0.f, 0.f, 0.f}, {0.f, 0.f, 0.f, 0.f}, {0.f, 0.f, 0.f, 0.f}};
#pragma unroll
          for (int ks = 0; ks < 8; ++ks) { const int k0 = F.wave * 256 + ks * 32 + 8 * fq; const bf16x8 af = *(const LAS bf16x8*)(Hs + fr * HS + k0);
#pragma unroll
              for (int n = 0; n < 3; ++n) { const bf16x8 bfr = *(const bf16x8*)(P.WRT + (size_t)(16 * n + fr) * D + k0); acc[n] = __builtin_amdgcn_mfma_f32_16x16x32_bf16(af, bfr, acc[n], 0, 0, 0); } }
#pragma unroll
          for (int n = 0; n < 3; ++n)
#pragma unroll
              for (int r = 0; r < 4; ++r) PART[(F.wave * 16 + 4 * fq + r) * 48 + 16 * n + fr] = acc[n][r]; }
        LDS_WAIT(); __syncthreads();
        for (int i = F.tid; i < 16 * 48; i += NTHREADS) { float s = 0.f;
#pragma unroll
            for (int w = 0; w < 8; ++w) s += PART[w * 768 + i];
            LOG[i] = s; }
        LDS_WAIT(); __syncthreads();
        if (F.tid < 16) { const int row = rowb + F.tid; const LAS float* lg = LOG + F.tid * 48;
            float best = lg[0] + P.brg[0]; int gi = 0;
#pragma unroll
            for (int i = 1; i < 4; ++i) { const float t = lg[i] + P.brg[i]; if (t > best) { best = t; gi = i; } }
            float den = 0.f;
#pragma unroll
            for (int i = 0; i < 4; ++i) den += expf(lg[i] + P.brg[i] - best);
            const float pg = 1.0f / den;
            float v1 = -3.0e38f, v2 = -3.0e38f; int i1 = 0, i2 = 0;
#pragma unroll
            for (int i = 0; i < 8; ++i) { const float t = lg[4 + gi * 8 + i] + P.bre[gi * 8 + i]; if (t > v1) { v2 = v1; i2 = i1; v1 = t; i1 = i; } else if (t > v2) { v2 = t; i2 = i; } }
            const float w1 = 1.0f / (1.0f + expf(v2 - v1)), w2 = 1.0f - w1; const int e1 = gi * 8 + i1, e2 = gi * 8 + i2;
            P.TOKE[row * 2] = e1; P.TOKE[row * 2 + 1] = e2; P.TOKW[row * 2] = pg * w1; P.TOKW[row * 2 + 1] = pg * w2;
            sel[F.tid * 4] = e1; sel[F.tid * 4 + 1] = e2; sel[F.tid * 4 + 2] = atomicAdd((int*)(lc + e1), 1); sel[F.tid * 4 + 3] = atomicAdd((int*)(lc + e2), 1); }
        LDS_WAIT(); __syncthreads();
        if (F.tid < 32) { const int n = lc[F.tid]; lc[32 + F.tid] = n > 0 ? (int)atomicAdd(P.cnt + F.tid, (unsigned)n) : 0; }
        LDS_WAIT(); __syncthreads();
        if (F.tid < 16) { const int row = rowb + F.tid, e1 = sel[F.tid * 4], e2 = sel[F.tid * 4 + 1];
            P.LIST[(size_t)e1 * NT + lc[32 + e1] + sel[F.tid * 4 + 2]] = row * 2; P.LIST[(size_t)e2 * NT + lc[32 + e2] + sel[F.tid * 4 + 3]] = row * 2 + 1; }
        __syncthreads();
    }
}
__device__ __forceinline__ void p9_final(Frame& F, const Ptrs& P) {
    const int gw = F.vcu * NWAVES + F.wave, NGW = F.G * NWAVES;
    for (int row = gw; row < NT; row += NGW) { const int b = row / SEQ;
        f32x4* xr = (f32x4*)(F.out + (size_t)row * D); const f32x4* gt = (const f32x4*)(P.MOD + (size_t)b * NMOD + 5 * D); f32x4 v[8]; float s = 0.f;
#pragma unroll
        for (int j = 0; j < 8; ++j) { const u32x2 ya = *(const u32x2*)(P.Y2 + (size_t)(row * 2) * D + (j * 64 + F.lane) * 4), yb = *(const u32x2*)(P.Y2 + (size_t)(row * 2 + 1) * D + (j * 64 + F.lane) * 4);
            f32x4 y; y[0] = __uint_as_float(ya.x << 16) + __uint_as_float(yb.x << 16); y[1] = __uint_as_float(ya.x & 0xffff0000u) + __uint_as_float(yb.x & 0xffff0000u);
            y[2] = __uint_as_float(ya.y << 16) + __uint_as_float(yb.y << 16); y[3] = __uint_as_float(ya.y & 0xffff0000u) + __uint_as_float(yb.y & 0xffff0000u);
            v[j] = xr[j * 64 + F.lane] * ALPHA + gt[j * 64 + F.lane] * y; s += (v[j][0] + v[j][1]) + (v[j][2] + v[j][3]); }
        const float mean = wave_sum(s) * (1.0f / D); float q = 0.f;
#pragma unroll
        for (int j = 0; j < 8; ++j) { v[j] = v[j] - mean; q += (v[j][0] * v[j][0] + v[j][1] * v[j][1]) + (v[j][2] * v[j][2] + v[j][3] * v[j][3]); }
        const float rstd = rsqrtf(wave_sum(q) * (1.0f / D) + EPS);
#pragma unroll
        for (int j = 0; j < 8; ++j) xr[j * 64 + F.lane] = v[j] * rstd * ((const f32x4*)P.ln2_g)[j * 64 + F.lane] + ((const f32x4*)P.ln2_b)[j * 64 + F.lane];
    }
}

namespace att {
typedef float f32x16 __attribute__((ext_vector_type(16)));
typedef short s16x4 __attribute__((ext_vector_type(4)));
constexpr int KTILE_B = 64 * 384, VTILE_B = 64 * 256, STAGE_B = KTILE_B + VTILE_B, NSTAGE = 3;
constexpr int SCR_OFF = NSTAGE * STAGE_B;
constexpr float THR2 = 11.0f;
__device__ __forceinline__ int crow(int r, int hi) { return (r & 3) + 8 * (r >> 2) + 4 * hi; }
__device__ __forceinline__ int v_rd_base(int lane) { return ((lane & 3) << 3) | (((lane >> 2) & 3) << 6) | (((lane >> 4) & 1) << 5) | (((lane >> 5) & 1) << 8); }
template <int OFF> __device__ __forceinline__ s16x4 tr_read(unsigned vb) { s16x4 r; asm volatile("ds_read_b64_tr_b16 %0, %1 offset:%2" : "=&v"(r) : "v"(vb), "i"(OFF) : "memory"); return r; }
#define ATT_SBAR() __builtin_amdgcn_sched_barrier(0)
template <int D0> __device__ __forceinline__ void pv_one(f32x16& od, unsigned vb, bf16x8 pa0, bf16x8 pa1) {
    const s16x4 l0 = tr_read<D0 * 512>(vb), h0 = tr_read<D0 * 512 + 2048>(vb), l1 = tr_read<D0 * 512 + 4096>(vb), h1 = tr_read<D0 * 512 + 4096 + 2048>(vb);
    asm volatile("s_waitcnt lgkmcnt(0)" ::: "memory"); ATT_SBAR();
#define ATT_PK(L, H) (bf16x8){L[0], L[1], L[2], L[3], H[0], H[1], H[2], H[3]}
    od = __builtin_amdgcn_mfma_f32_32x32x16_bf16(pa0, ATT_PK(l0, h0), od, 0, 0, 0);
    od = __builtin_amdgcn_mfma_f32_32x32x16_bf16(pa1, ATT_PK(l1, h1), od, 0, 0, 0);
#undef ATT_PK
}
__device__ __forceinline__ void attn_phase(Frame& F, const Ptrs& P) {
    LAS unsigned char* lds = F.lds;
    const int lane = F.lane, w = F.wave, rg = w & 3, kh = w >> 2, r32 = lane & 31, hi = lane >> 5;
    unsigned soff[5];
#pragma unroll
    for (int q = 0; q < 5; ++q) { const int ii = w * 5 + q;
        if (ii < 24) { const int sidx = ii * 64 + lane, r = sidx / 24, cs = sidx % 24, c = cs ^ ((r >> 1) & 7); soff[q] = (unsigned)(r * 384 + c * 16); }
        else { const int o = ((ii - 24) * 64 + lane) * 16, sub = o >> 9, rem = o & 511, kk = (sub >> 2) * 8 + (rem >> 6), k = (kk & ~0xC) | ((kk & 4) << 1) | ((kk & 8) >> 1), col = (sub & 3) * 32 + ((rem & 63) >> 1);
            soff[q] = (unsigned)(k * 256 + col * 2); } }
    const int kr = 32 * kh + r32, kx = (kr >> 1) & 7;
    unsigned ka[4];
#pragma unroll
    for (int j = 0; j < 4; ++j) ka[j] = (unsigned)(kr * 384 + ((((j << 1) | hi) ^ kx) << 4));
    const unsigned vb0 = (unsigned)(KTILE_B + kh * 8192 + v_rd_base(lane));
    LAS float* scr = (LAS float*)(lds + SCR_OFF + w * 256);
#define ATT_ISSUE(tile, stage) do { const size_t _ko = (size_t)(tile) * (64 * 384), _vo = (size_t)(tile) * (64 * 256); \
        _Pragma("unroll") for (int q = 0; q < 5; ++q) { const int ii = w * 5 + q; \
            if (ii < 24) __builtin_amdgcn_global_load_lds((const unsigned*)(Kh + _ko + soff[q]), (LAS unsigned*)(lds + (stage) * STAGE_B + ii * 1024), 16, 0, 0); \
            else __builtin_amdgcn_global_load_lds((const unsigned*)(Vh + _vo + soff[q]), (LAS unsigned*)(lds + (stage) * STAGE_B + KTILE_B + (ii - 24) * 1024), 16, 0, 0); } } while (0)
    for (int item = F.vcu; item < NB * NH * 8; item += F.G) {
        const int bh = item >> 3, pr = item & 7, b = bh >> 3, h = bh & 7;
        const char* Kh = (const char*)(P.Kb + (size_t)bh * SEQ * QKD); const char* Vh = (const char*)(P.Vb + (size_t)bh * SEQ * VD);
        for (int blk = 0; blk < 2; ++blk) {
            const int x = blk == 0 ? 15 - pr : pr, q0 = x * 128, nt = 2 * (x + 1);
            bf16x8 qr[12];
            { const bf16* Qw = P.Qb + ((size_t)bh * SEQ + q0 + 32 * rg + r32) * QKD + hi * 8;
#pragma unroll
              for (int d0 = 0; d0 < 12; ++d0) qr[d0] = *(const bf16x8*)(Qw + 16 * d0); }
            ATT_ISSUE(0, 0); ATT_ISSUE(1, 1);
            f32x16 o[4];
#pragma unroll
            for (int d = 0; d < 4; ++d)
#pragma unroll
                for (int r = 0; r < 16; ++r) o[d][r] = 0.f;
            float m_run = -1.0e30f, l_run = 0.f;
            int st = 0;
            for (int t = 0; t < nt; ++t) {
                if (t + 1 < nt) asm volatile("s_waitcnt vmcnt(5)" ::: "memory"); else asm volatile("s_waitcnt vmcnt(0)" ::: "memory");
                asm volatile("s_waitcnt lgkmcnt(0)" ::: "memory"); __builtin_amdgcn_s_barrier(); asm volatile("" ::: "memory");
                if (t + 2 < nt) { const int s2 = st == 0 ? 2 : st - 1; ATT_ISSUE(t + 2, s2); }
                const int diag = t - 2 * x, kb = 2 * diag + kh;
                const bool skip = diag >= 0 && kb > rg, domask = diag >= 0 && kb == rg;
                if (!skip) {
                    const unsigned sb = (unsigned)(st * STAGE_B);
                    f32x16 p0;
#pragma unroll
                    for (int r = 0; r < 16; ++r) p0[r] = 0.f;
#pragma unroll
                    for (int d0 = 0; d0 < 12; ++d0) { const bf16x8 kf = *(const LAS bf16x8*)(lds + sb + ka[d0 & 3] + 128 * (d0 >> 2)); p0 = __builtin_amdgcn_mfma_f32_32x32x16_bf16(kf, qr[d0], p0, 0, 0, 0); }
                    if (domask) {
#pragma unroll
                        for (int r = 0; r < 16; ++r) if (crow(r, hi) > r32) p0[r] = -INFINITY; }
                    float pmax = p0[0];
#pragma unroll
                    for (int r = 1; r < 16; ++r) pmax = fmaxf(pmax, p0[r]);
                    { auto rr = __builtin_amdgcn_permlane32_swap(__float_as_uint(pmax), __float_as_uint(pmax), false, false); pmax = fmaxf(__uint_as_float(rr[0]), __uint_as_float(rr[1])); }
                    float mn, alpha;
                    if (__builtin_expect(__all(pmax - m_run <= THR2), 1)) { mn = m_run; alpha = 1.f; }
                    else { mn = fmaxf(m_run, pmax); alpha = __builtin_amdgcn_exp2f(m_run - mn); m_run = mn; }
                    float ps = 0.f;
#pragma unroll
                    for (int r = 0; r < 16; ++r) { p0[r] = __builtin_amdgcn_exp2f(p0[r] - mn); ps += p0[r]; }
                    { auto rr = __builtin_amdgcn_permlane32_swap(__float_as_uint(ps), __float_as_uint(ps), false, false); ps = __uint_as_float(rr[0]) + __uint_as_float(rr[1]); }
                    l_run = l_run * alpha + ps;
                    if (__any(alpha < 1.f)) { if (hi == 0) scr[r32] = alpha; asm volatile("s_waitcnt lgkmcnt(0)" ::: "memory");
#pragma unroll
                        for (int r = 0; r < 16; ++r) { const float a = scr[crow(r, hi)];
#pragma unroll
                            for (int d = 0; d < 4; ++d) o[d][r] *= a; } }
                    bf16x8 pa0, pa1;
#define ATT_PK4(BASE, OUT) do { const unsigned a0 = cvt_pk_bf16(p0[BASE + 0], p0[BASE + 1]), a1 = cvt_pk_bf16(p0[BASE + 2], p0[BASE + 3]), b0 = cvt_pk_bf16(p0[BASE + 4], p0[BASE + 5]), b1 = cvt_pk_bf16(p0[BASE + 6], p0[BASE + 7]); \
                        auto r0 = __builtin_amdgcn_permlane32_swap(a0, b0, false, false); auto r1 = __builtin_amdgcn_permlane32_swap(a1, b1, false, false); \
                        u32x4 wv = {r0[0], r1[0], r0[1], r1[1]}; OUT = __builtin_bit_cast(bf16x8, wv); } while (0)
                    ATT_PK4(0, pa0); ATT_PK4(8, pa1);
#undef ATT_PK4
                    const unsigned vb = vb0 + sb;
                    pv_one<0>(o[0], vb, pa0, pa1); pv_one<1>(o[1], vb, pa0, pa1); pv_one<2>(o[2], vb, pa0, pa1); pv_one<3>(o[3], vb, pa0, pa1);
                }
                st = st == 2 ? 0 : st + 1;
            }
            asm volatile("s_waitcnt lgkmcnt(0)" ::: "memory"); __builtin_amdgcn_s_barrier(); asm volatile("" ::: "memory");
            LAS float* O2 = (LAS float*)(lds + rg * 16384);
            LAS float* ML = (LAS float*)(lds + 65536 + rg * 256);
            if (kh == 1) {
#pragma unroll
                for (int d = 0; d < 4; ++d)
#pragma unroll
                    for (int r = 0; r < 16; ++r) O2[(d * 16 + r) * 64 + lane] = o[d][r];
                if (hi == 0) { ML[r32] = m_run; ML[32 + r32] = l_run; }
            }
            asm volatile("s_waitcnt lgkmcnt(0)" ::: "memory"); __builtin_amdgcn_s_barrier(); asm volatile("" ::: "memory");
            if (kh == 0) {
                const float m2 = ML[r32], l2 = ML[32 + r32], m = fmaxf(m_run, m2), a1 = __builtin_amdgcn_exp2f(m_run - m), a2 = __builtin_amdgcn_exp2f(m2 - m);
                const float inv = 1.0f / (l_run * a1 + l2 * a2);
                if (hi == 0) { scr[r32] = a1 * inv; scr[32 + r32] = a2 * inv; }
                asm volatile("s_waitcnt lgkmcnt(0)" ::: "memory");
                bf16* orow = P.A2 + (size_t)(b * SEQ + q0 + 32 * rg) * D + h * VD + r32;
#pragma unroll
                for (int r = 0; r < 16; ++r) { const int qr_ = crow(r, hi); const float f1 = scr[qr_], f2 = scr[32 + qr_];
#pragma unroll
                    for (int d = 0; d < 4; ++d) orow[(size_t)qr_ * D + 32 * d] = f2bf(o[d][r] * f1 + O2[(d * 16 + r) * 64 + lane] * f2); }
            }
            asm volatile("s_waitcnt lgkmcnt(0)" ::: "memory"); __builtin_amdgcn_s_barrier(); asm volatile("" ::: "memory");
        }
    }
#undef ATT_ISSUE
}
#undef ATT_SBAR
}

__global__ void __launch_bounds__(NTHREADS, 2) mega_fwd(Args args) {
    extern __shared__ __attribute__((aligned(16))) unsigned char lds_raw[];
    Frame F; F.lds = (LAS unsigned char*)lds_raw; F.MISC = (volatile LAS unsigned*)(F.lds + MISC_OFF);
    F.tid = threadIdx.x; F.lane = F.tid & 63; F.wave = __builtin_amdgcn_readfirstlane(F.tid >> 6);
    F.G = gridDim.x; { const int bx = blockIdx.x; F.vcu = (F.G % 8 == 0) ? (bx % 8) * (F.G / 8) + bx / 8 : bx; }
    F.ws = args.ws; F.out = args.out;
    unsigned char* ws = args.ws;
    Ptrs P;
    P.x = (const float*)args.in[0]; P.c = (const float*)args.in[1]; P.positions = (const int*)args.in[2]; P.w_ada = (const float*)args.in[3]; P.b_ada = (const float*)args.in[4]; P.w_in = (const float*)args.in[5];
    P.q_norm_g = (const float*)args.in[6]; P.w_uq = (const float*)args.in[7]; P.kv_norm_g = (const float*)args.in[8]; P.w_ukv = (const float*)args.in[9]; P.sgu_g = (const float*)args.in[10]; P.sgu_b = (const float*)args.in[11];
    P.w_sp = (const float*)args.in[12]; P.b_sp = (const float*)args.in[13]; P.w_o = (const float*)args.in[14]; P.ln1_g = (const float*)args.in[15]; P.ln1_b = (const float*)args.in[16];
    P.wrg = (const float*)args.in[17]; P.brg = (const float*)args.in[18]; P.wre = (const float*)args.in[19]; P.bre = (const float*)args.in[20];
    P.w_gate = (const float*)args.in[21]; P.w_up = (const float*)args.in[22]; P.w_down = (const float*)args.in[23]; P.ln2_g = (const float*)args.in[24]; P.ln2_b = (const float*)args.in[25];
    P.MOD = (float*)(ws + WS_MOD); P.RT = (float2*)(ws + WS_ROPE); P.SSQQ = (float*)(ws + WS_SSQQ); P.SSQKV = (float*)(ws + WS_SSQKV); P.VSST = (float*)(ws + WS_VSST);
    P.TOKE = (int*)(ws + WS_TOKE); P.TOKW = (float*)(ws + WS_TOKW); P.LIST = (int*)(ws + WS_LIST); P.cnt = (unsigned*)(ws + WS_CTL) + CW_CNT;
    P.WIN = (bf16*)(ws + WS_WIN); P.WUQ = (bf16*)(ws + WS_WUQ); P.WUKV = (bf16*)(ws + WS_WUKV); P.WO = (bf16*)(ws + WS_WO); P.WGU = (bf16*)(ws + WS_WGU); P.WDN = (bf16*)(ws + WS_WDN); P.WSP = (bf16*)(ws + WS_WSP); P.WRT = (bf16*)(ws + WS_WR);
    P.H = (bf16*)(ws + WS_H); P.CQ = (bf16*)(ws + WS_CQ); P.CKV = (bf16*)(ws + WS_CKV); P.U = (bf16*)(ws + WS_U); P.VS = (bf16*)(ws + WS_VS);
    P.Qb = (bf16*)(ws + WS_Q); P.Kb = (bf16*)(ws + WS_K); P.Vb = (bf16*)(ws + WS_V); P.A2 = (bf16*)(ws + WS_A2); P.HID = (bf16*)(ws + WS_HID); P.Y2 = (bf16*)(ws + WS_Y2);

    for (int u = F.tid; u < 64; u += NTHREADS) ((LAS unsigned*)(F.lds + MISC_OFF))[u] = 0u;
    __syncthreads();
    const int lo = args.ph_lo, hi = args.ph_hi;
    unsigned* barw = (unsigned*)(ws + WS_CTL) + CW_BAR + args.li * XCD_BAR_WORDS;
    XcdBarrier bar; bar.bar = barw; bar.x = 0; bar.st = nullptr;
    if (hi - lo > 1) bar = xcd_barrier_post(barw, F.MISC + 8);
#define IN(k) (lo <= (k) && (k) < hi)
#define SEAM(k) do { if (IN(k) && IN((k) + 1)) xcd_barrier(bar); } while (0)

    if (IN(0)) { p0_prologue(F, P); } SEAM(0);
    if (IN(1)) { p1_lnmod(F, P); } SEAM(1);
    if (IN(2)) {
        pg8::DenseOrder S; S.init(P.H, D, P.WIN, D, NT, 3584, F.G, (int)blockIdx.x);
        EpiProj E{P.CQ, P.CKV, P.U, P.VS, P.Kb, P.SSQQ, P.SSQKV, P.VSST, P.RT};
        pg8::gemm_phase<EpiProj, pg8::DenseOrder, false, true>(F.lds, D, D, S, E);
    } SEAM(2);
    if (IN(3)) {
        { pg8::DenseOrder S; S.init(P.CQ, QL, P.WUQ, QL, NT, NH * QKD, F.G, (int)blockIdx.x); EpiQ E{P.SSQQ, P.RT, P.Qb};
          pg8::gemm_phase<EpiQ, pg8::DenseOrder, false, true>(F.lds, QL, QL, S, E); }
        { pg8::DenseOrder S; S.init(P.CKV, KVL, P.WUKV, KVL, NT, NH * 256, F.G, (int)blockIdx.x); EpiKV E{P.SSQKV, P.Kb, P.Vb};
          pg8::gemm_phase<EpiKV, pg8::DenseOrder, false, true>(F.lds, KVL, KVL, S, E); }
        sgu_units(F, P);
    } SEAM(3);
    if (IN(4)) { att::attn_phase(F, P); } SEAM(4);
    if (IN(5)) {
        pg8::DenseOrder S; S.init(P.A2, D, P.WO, D, NT, D, F.G, (int)blockIdx.x); EpiWo E{P.x, P.MOD, F.out};
        pg8::gemm_phase<EpiWo, pg8::DenseOrder, false, true>(F.lds, D, D, S, E);
    } SEAM(5);
    if (IN(6)) { p6_mid(F, P); } SEAM(6);
    if (IN(7)) {
        moe_build_table(F, P.cnt);
        MoeOrder S; S.tab = (const LAS int*)(F.lds + TAB_OFF); S.A = (const char*)P.H; S.Bt = (const char*)P.WGU; S.LIST = P.LIST; S.ntn = 4; S.G = F.G; S.c = (int)blockIdx.x;
        S.bstep_e = (size_t)1024 * D * 2; S.bstep_n = (size_t)256 * D * 2; S.astep = 0;
        EpiGU E{P.HID};
        pg8::gemm_phase<EpiGU, MoeOrder, true, true>(F.lds, D, D, S, E);
    } SEAM(7);
    if (IN(8)) {
        moe_build_table(F, P.cnt);
        MoeOrder S; S.tab = (const LAS int*)(F.lds + TAB_OFF); S.A = (const char*)P.HID; S.Bt = (const char*)P.WDN; S.LIST = P.LIST; S.ntn = 8; S.G = F.G; S.c = (int)blockIdx.x;
        S.bstep_e = (size_t)D * FF * 2; S.bstep_n = (size_t)256 * FF * 2; S.astep = (size_t)256 * FF * 2;
        EpiDown E{P.LIST, P.TOKW, P.Y2};
        pg8::gemm_phase<EpiDown, MoeOrder, false, true>(F.lds, FF, FF, S, E);
    } SEAM(8);
    if (IN(9)) { p9_final(F, P); }
#undef IN
#undef SEAM
}

#ifndef MEGA_MASK
#define MEGA_MASK 0x3ff
#endif
extern "C" void kernel_launch(void* const* d_in, const int* in_sizes, int n_in, void* d_out, int out_size, void* d_ws, size_t ws_size, hipStream_t stream) {
    if (n_in != 26 || out_size != NT * D || ws_size < WS_END) { fprintf(stderr, "kernel_launch: unexpected shapes (n_in %d out %d ws %zu)\n", n_in, out_size, ws_size); return; }
    const float* x = (const float*)d_in[0]; const float* c = (const float*)d_in[1]; const int* positions = (const int*)d_in[2];
    const float* w_ada = (const float*)d_in[3]; const float* b_ada = (const float*)d_in[4]; const float* w_in = (const float*)d_in[5];
    const float* q_norm_g = (const float*)d_in[6]; const float* w_uq = (const float*)d_in[7]; const float* kv_norm_g = (const float*)d_in[8]; const float* w_ukv = (const float*)d_in[9];
    const float* sgu_g = (const float*)d_in[10]; const float* sgu_b = (const float*)d_in[11]; const float* w_sp = (const float*)d_in[12]; const float* b_sp = (const float*)d_in[13];
    const float* w_o = (const float*)d_in[14]; const float* ln1_g = (const float*)d_in[15]; const float* ln1_b = (const float*)d_in[16];
    const float* wrg = (const float*)d_in[17]; const float* brg = (const float*)d_in[18]; const float* wre = (const float*)d_in[19]; const float* bre = (const float*)d_in[20];
    const float* w_gate = (const float*)d_in[21]; const float* w_up = (const float*)d_in[22]; const float* w_down = (const float*)d_in[23];
    const float* ln2_g = (const float*)d_in[24]; const float* ln2_b = (const float*)d_in[25];
    unsigned char* ws = (unsigned char*)d_ws; float* out = (float*)d_out;
    float* MOD = (float*)(ws + WS_MOD); float2* RT = (float2*)(ws + WS_ROPE); float* SSQQ = (float*)(ws + WS_SSQQ); float* SSQKV = (float*)(ws + WS_SSQKV); float* VSST = (float*)(ws + WS_VSST);
    int* TOKE = (int*)(ws + WS_TOKE); float* TOKW = (float*)(ws + WS_TOKW); int* LIST = (int*)(ws + WS_LIST); unsigned* cnt = (unsigned*)(ws + WS_CTL) + CW_CNT;
    bf16* H = (bf16*)(ws + WS_H); bf16* CQ = (bf16*)(ws + WS_CQ); bf16* CKV = (bf16*)(ws + WS_CKV); bf16* U = (bf16*)(ws + WS_U); bf16* VS = (bf16*)(ws + WS_VS);
    bf16* Qb = (bf16*)(ws + WS_Q); bf16* Kb = (bf16*)(ws + WS_K); bf16* Vb = (bf16*)(ws + WS_V); bf16* A2 = (bf16*)(ws + WS_A2); bf16* HID = (bf16*)(ws + WS_HID); bf16* Y2 = (bf16*)(ws + WS_Y2);
    float* KPERAW = (float*)(ws + WS_KPERAW); float* QPERAW = (float*)(ws + WS_QPERAW); float* G = (float*)(ws + WS_G);

    static int grid = 0;
    if (grid == 0) {
        int dev = 0, cus = 0;
        if (hipGetDevice(&dev) != hipSuccess || hipDeviceGetAttribute(&cus, hipDeviceAttributeMultiprocessorCount, dev) != hipSuccess) { fprintf(stderr, "kernel_launch: device query failed\n"); grid = -1; return; }
        if (hipFuncSetAttribute((const void*)mega_fwd, hipFuncAttributeMaxDynamicSharedMemorySize, LDS_BYTES) != hipSuccess) { fprintf(stderr, "kernel_launch: hipFuncSetAttribute failed\n"); grid = -1; return; }
        int per_cu = 0; (void)hipOccupancyMaxActiveBlocksPerMultiprocessor(&per_cu, (const void*)mega_fwd, NTHREADS, LDS_BYTES); (void)hipGetLastError();
        if (per_cu < 1) fprintf(stderr, "kernel_launch: occupancy query reports %d blocks per CU\n", per_cu);
        grid = cus;
    }
    if (grid < 0) return;
    (void)hipMemsetAsync(ws + WS_CTL, 0, CTL_BYTES, stream);
    Args a{}; for (int i = 0; i < 26; ++i) a.in[i] = d_in[i]; a.out = out; a.ws = ws;
    const unsigned mask = MEGA_MASK;
    int p = 0, li = 0;
    while (p < NPH) {
        if (mask & (1u << p)) { int q = p; while (q < NPH && (mask & (1u << q))) ++q; a.ph_lo = p; a.ph_hi = q; a.li = li++; hipLaunchKernelGGL(mega_fwd, dim3(grid), dim3(NTHREADS), LDS_BYTES, stream, a); p = q; continue; }
        switch (p) {
        case 0: hipLaunchKernelGGL(mega_fwd, dim3(grid), dim3(NTHREADS), LDS_BYTES, stream, (a.ph_lo = 0, a.ph_hi = 1, a.li = li++, a));
                n_mod<<<NMOD / 256, 256, 0, stream>>>(c, w_ada, b_ada, MOD); n_rope_table<<<NT * 32 / 256, 256, 0, stream>>>(positions, RT); break;
        case 1: n_ln_mod<<<NT / 4, 256, 0, stream>>>(x, MOD, 0, D, H); break;
        case 2: n_gemm<<<dim3(INP / 64, NT / 64), 256, 0, stream>>>(NT, D, AL_bf16{H, D, 0}, BL_plain{w_in, INP, 0}, EP_proj{CQ, CKV, KPERAW, U, VS});
                n_rowstats<<<NT / 4, 256, 0, stream>>>(CQ, CKV, VS, KPERAW, RT, SSQQ, SSQKV, VSST, Kb); break;
        case 3: n_gemm<<<dim3(NH * QKD / 64, NT / 64), 256, 0, stream>>>(NT, QL, AL_bf16{CQ, QL, 0}, BL_rowscale{w_uq, NH * QKD, 0, q_norm_g}, EP_q{SSQQ, Qb, QPERAW});
                n_rope_q<<<NT * NH * 32 / 256, 256, 0, stream>>>(QPERAW, RT, Qb);
                n_gemm<<<dim3(NH * 256 / 64, NT / 64), 256, 0, stream>>>(NT, KVL, AL_bf16{CKV, KVL, 0}, BL_rowscale{w_ukv, NH * 256, 0, kv_norm_g}, EP_kv{SSQKV, Kb, Vb});
                n_sgu<<<dim3(NT / CH, NG), 256, 0, stream>>>(U, VS, VSST, sgu_g, sgu_b, w_sp, b_sp, A2); break;
        case 4: n_attn<<<dim3(SEQ / 16, NH, NB), 256, 0, stream>>>(Qb, Kb, Vb, A2); break;
        case 5: n_gemm<<<dim3(D / 64, NT / 64), 256, 0, stream>>>(NT, D, AL_bf16{A2, D, 0}, BL_plain{w_o, D, 0}, EP_wo{x, MOD, out}); break;
        case 6: n_mid<<<NT / 4, 256, 0, stream>>>(out, MOD, ln1_g, ln1_b, wrg, brg, wre, bre, H, TOKE, TOKW, cnt, LIST); break;
        case 7: n_moe_gu<<<dim3(FF / 64, NT / 64, NE), 256, 0, stream>>>(H, w_gate, w_up, cnt, LIST, G, HID, 0);
                n_moe_gu<<<dim3(FF / 64, NT / 64, NE), 256, 0, stream>>>(H, w_gate, w_up, cnt, LIST, G, HID, 1); break;
        case 8: n_moe_dn<<<dim3(D / 64, NT / 64, NE), 256, 0, stream>>>(HID, w_down, cnt, LIST, TOKW, Y2); break;
        case 9: n_final<<<NT / 4, 256, 0, stream>>>(out, Y2, MOD, ln2_g, ln2_b); break;
        }
        ++p;
    }
}
```
